# Optimizing an MI355X kernel written in HIP

```python
import math
import jax, jax.numpy as jnp
from jax import lax
import numpy as np

D_MODEL = 2048
BATCH = 2
SEQ = 4096
DEPTH = 4
DEC_BATCH = 8
DEC_SEQ = 4
PAST_LEN = 16384
PAGE_SIZE = 128

N_MIXERS = 2
N_LRU = (DEPTH + 1) // 2
N_ATTN = DEPTH // 2
LRU_WIDTH = D_MODEL
LRU_HEADS = 8
LRU_HEAD_DIM = LRU_WIDTH // LRU_HEADS
LRU_CONV = 4
LRU_C = 8.0
ATTN_GROUPS = ((128, 1), (512, 4), (2048, 16))
N_GROUPS = len(ATTN_GROUPS)
GROUP_HEADS = 8
HEAD_DIM = 128
ATTN_WIDTH = GROUP_HEADS * HEAD_DIM
QKV_WIDTH = N_GROUPS * 3 * GROUP_HEADS * HEAD_DIM
D_FF = 3 * D_MODEL
FFN_CONV = 3
EPS = 1e-6
NEG = -1e30

kernel_name = 'hybrid_rglru_dilated_swa_convffn_step'


def rms_norm(x, g):
    xf = x.astype(jnp.float32)
    y = xf * lax.rsqrt(jnp.mean(xf * xf, axis=-1, keepdims=True) + EPS) * g.astype(jnp.float32)
    return y.astype(x.dtype)


def causal_dwconv(ext, w, b):
    K = w.shape[0]
    L = ext.shape[1] - K + 1
    out = b
    for k in range(K):
        out = out + ext[:, k:k + L] * w[k]
    return out


def _lin_comb(left, right):
    a1, b1 = left
    a2, b2 = right
    return a1 * a2, a2 * b1 + b2


def rg_lru(u, h0, w_a, b_a, w_i, b_i, lam):
    B, L, W = u.shape
    uf = u.astype(jnp.float32)
    ub = uf.reshape(B, L, LRU_HEADS, LRU_HEAD_DIM)
    r = jax.nn.sigmoid(jnp.einsum('blhi,hij->blhj', ub, w_a.astype(jnp.float32)).reshape(B, L, W) + b_a.astype(jnp.float32))
    ig = jax.nn.sigmoid(jnp.einsum('blhi,hij->blhj', ub, w_i.astype(jnp.float32)).reshape(B, L, W) + b_i.astype(jnp.float32))
    log_a = -LRU_C * r * jax.nn.softplus(-lam.astype(jnp.float32))
    a = jnp.exp(log_a)
    bx = jnp.sqrt(-jnp.expm1(2.0 * log_a)) * (ig * uf)
    bx = bx.at[:, 0].add(a[:, 0] * h0.astype(jnp.float32))
    _, h = lax.associative_scan(_lin_comb, (a, bx), axis=1)
    return h.astype(u.dtype), h[:, -1].astype(u.dtype)


def recurrent_block(x, h0, conv_buf, w_in, b_in, conv_w, conv_b, w_a, b_a, w_i, b_i, lam, w_out, b_out):
    proj = x @ w_in + b_in
    gate, u = jnp.split(proj, 2, axis=-1)
    u_ext = jnp.concatenate([conv_buf.astype(u.dtype), u], axis=1)
    uc = causal_dwconv(u_ext, conv_w, conv_b)
    h, h_last = rg_lru(uc, h0, w_a, b_a, w_i, b_i, lam)
    y = (h * jax.nn.gelu(gate)) @ w_out + b_out
    return y, h_last, u_ext[:, u_ext.shape[1] - (LRU_CONV - 1):]


def conv_ffn(x, conv_buf, w_up, conv_w, conv_b, w_down):
    up = x @ w_up
    up_ext = jnp.concatenate([conv_buf.astype(up.dtype), up], axis=1)
    c = causal_dwconv(up_ext, conv_w, conv_b)
    g, v = jnp.split(c, 2, axis=-1)
    y = (jax.nn.gelu(g) * v) @ w_down
    return y, up_ext[:, up_ext.shape[1] - (FFN_CONV - 1):]


def alibi_slopes():
    n = N_GROUPS * GROUP_HEADS
    s = 2.0 ** (-8.0 * np.arange(1, n + 1) / n)
    return jnp.asarray(s, dtype=jnp.float32).reshape(N_GROUPS, GROUP_HEADS)


def dilated_group_prompt(q, k, v, window, dil, slopes):
    B, S, H, Dh = q.shape
    blk = window // dil
    L = -(-S // dil)
    L = -(-L // blk) * blk
    nb = L // blk
    pad = L * dil - S

    def phase(t):
        t = jnp.pad(t, ((0, 0), (0, pad), (0, 0), (0, 0)))
        t = t.reshape(B, L, dil, H, Dh).transpose(0, 2, 1, 3, 4)
        return t.reshape(B, dil, nb, blk, H, Dh)

    def with_prev(t):
        prev = jnp.pad(t, ((0, 0), (0, 0), (1, 0), (0, 0), (0, 0), (0, 0)))[:, :, :-1]
        return jnp.concatenate([prev, t], axis=3)

    qb = phase(q)
    kk = with_prev(phase(k))
    vv = with_prev(phase(v))
    s = jnp.einsum('bpnihd,bpnjhd->bpnhij', qb, kk).astype(jnp.float32) / math.sqrt(Dh)
    i = jnp.arange(blk)[:, None]
    j = jnp.arange(2 * blk)[None, :]
    steps = i + blk - j
    n = jnp.arange(nb)[:, None, None]
    valid = (steps >= 0) & (steps <= blk) & ((n > 0) | (j >= blk))
    bias = -slopes[:, None, None] * (steps * dil).astype(jnp.float32)
    s = jnp.where(valid[None, None, :, None], s + bias, NEG)
    m = jnp.max(s, axis=-1, keepdims=True)
    e = jnp.exp(s - m)
    den = jnp.sum(e, axis=-1)
    lse = m[..., 0] + jnp.log(den)
    o = jnp.einsum('bpnhij,bpnjhd->bpnihd', e, vv.astype(jnp.float32)) / jnp.swapaxes(den, 3, 4)[..., None]
    o = o.reshape(B, dil, L, H, Dh).transpose(0, 2, 1, 3, 4).reshape(B, L * dil, H, Dh)[:, :S]
    lse = jnp.swapaxes(lse, 3, 4).reshape(B, dil, L, H).transpose(0, 2, 1, 3).reshape(B, L * dil, H)[:, :S]
    return o, lse


def dilated_group_sample(q, k_all, v_all, window, dil, slopes):
    B, T, H, Dh = q.shape
    wb = k_all.shape[1] - T
    steps = jnp.arange(window // dil + 1)
    idx = wb + jnp.arange(T)[:, None] - steps[None, :] * dil
    valid = idx >= 0
    idxc = jnp.maximum(idx, 0)
    kg = k_all[:, idxc]
    vg = v_all[:, idxc]
    dist = (steps * dil).astype(jnp.float32)
    s = jnp.einsum('bthd,btkhd->bthk', q, kg).astype(jnp.float32) / math.sqrt(Dh) - slopes[:, None] * dist[None, :]
    s = jnp.where(valid[:, None, :], s, NEG)
    m = jnp.max(s, axis=-1, keepdims=True)
    e = jnp.exp(s - m)
    den = jnp.sum(e, axis=-1)
    lse = m[..., 0] + jnp.log(den)
    o = jnp.einsum('bthk,btkhd->bthd', e, vg.astype(jnp.float32)) / den[..., None]
    return o, lse


def attention_block(x, kv_bufs, w_qkv, w_o):
    B, L, _ = x.shape
    qkv = (x @ w_qkv).reshape(B, L, N_GROUPS, 3, GROUP_HEADS, HEAD_DIM)
    slopes = alibi_slopes()
    outs, lses, new_kv = [], [], []
    for g, (win, dil) in enumerate(ATTN_GROUPS):
        q, k, v = qkv[:, :, g, 0], qkv[:, :, g, 1], qkv[:, :, g, 2]
        if kv_bufs is None:
            o, lse = dilated_group_prompt(q, k, v, win, dil, slopes[g])
            keep = min(win, L)
            new_kv.append(jnp.stack([k[:, L - keep:], v[:, L - keep:]], axis=2))
        else:
            buf = kv_bufs[g].astype(k.dtype)
            k_all = jnp.concatenate([buf[:, :, 0], k], axis=1)
            v_all = jnp.concatenate([buf[:, :, 1], v], axis=1)
            o, lse = dilated_group_sample(q, k_all, v_all, win, dil, slopes[g])
            new_kv.append(jnp.stack([k, v], axis=2))
        outs.append(o)
        lses.append(lse)
    wgt = jax.nn.softmax(jnp.stack(lses, axis=0), axis=0)
    o = jnp.sum(jnp.stack(outs, axis=0) * wgt[..., None], axis=0)
    y = o.reshape(B, L, ATTN_WIDTH).astype(x.dtype) @ w_o
    return y, new_kv


def run_trunk(x, lru_h, lru_conv, kv_caches, ffn_conv, norm_mix, norm_ffn, norm_final, lru_p, attn_p, ffn_p):
    new_h, new_lconv, new_fconv = [], [], []
    new_kv = [[] for _ in ATTN_GROUPS]
    for layer in range(DEPTH):
        j = layer // N_MIXERS
        xn = rms_norm(x, norm_mix[layer])
        if layer % N_MIXERS == 0:
            y, h_last, c_rows = recurrent_block(xn, lru_h[j], lru_conv[j], *[p[j] for p in lru_p])
            new_h.append(h_last)
            new_lconv.append(c_rows)
        else:
            bufs = None if kv_caches is None else [c[j] for c in kv_caches]
            y, kv_rows = attention_block(xn, bufs, attn_p[0][j], attn_p[1][j])
            for g in range(N_GROUPS):
                new_kv[g].append(kv_rows[g])
        x = x + y
        y, f_rows = conv_ffn(rms_norm(x, norm_ffn[layer]), ffn_conv[layer], *[p[layer] for p in ffn_p])
        new_fconv.append(f_rows)
        x = x + y
    out = rms_norm(x, norm_final)
    kv_out = [jnp.stack(rows, axis=0) for rows in new_kv]
    return out, jnp.stack(new_h, 0), jnp.stack(new_lconv, 0), kv_out, jnp.stack(new_fconv, 0)


def setup_inputs(seed: int = 0) -> dict:
    key = jax.random.key(seed)
    ks = jax.random.split(key, 32)
    f32 = jnp.float32
    nrm = lambda k, shape, scale: jax.random.normal(k, shape, f32) * scale
    a_c = jax.random.uniform(ks[0], (N_LRU, LRU_WIDTH), f32, minval=0.9, maxval=0.999)
    a_base = a_c ** (1.0 / LRU_C)
    lam = jnp.log(a_base) - jnp.log1p(-a_base)
    wbufs = [min(w, PAST_LEN) for (w, _) in ATTN_GROUPS]
    return {
        'x_prompt': nrm(ks[1], (BATCH, SEQ, D_MODEL), 1.0),
        'x_sample': nrm(ks[2], (DEC_BATCH, DEC_SEQ, D_MODEL), 1.0),
        'cache_kv_w128': nrm(ks[3], (N_ATTN, DEC_BATCH, wbufs[0], 2, GROUP_HEADS, HEAD_DIM), 1.0),
        'cache_kv_w512': nrm(ks[4], (N_ATTN, DEC_BATCH, wbufs[1], 2, GROUP_HEADS, HEAD_DIM), 1.0),
        'cache_kv_w2048': nrm(ks[5], (N_ATTN, DEC_BATCH, wbufs[2], 2, GROUP_HEADS, HEAD_DIM), 1.0),
        'state_lru_h': nrm(ks[6], (N_LRU, DEC_BATCH, LRU_WIDTH), 0.5),
        'state_lru_conv': nrm(ks[7], (N_LRU, DEC_BATCH, LRU_CONV - 1, LRU_WIDTH), 1.0),
        'state_ffn_conv': nrm(ks[8], (DEPTH, DEC_BATCH, FFN_CONV - 1, 2 * D_FF), 1.0),
        'norm_mix': 1.0 + nrm(ks[9], (DEPTH, D_MODEL), 0.01),
        'norm_ffn': 1.0 + nrm(ks[10], (DEPTH, D_MODEL), 0.01),
        'norm_final': 1.0 + nrm(ks[11], (D_MODEL,), 0.01),
        'lru_w_in': nrm(ks[12], (N_LRU, D_MODEL, 2 * LRU_WIDTH), D_MODEL ** -0.5),
        'lru_b_in': nrm(ks[13], (N_LRU, 2 * LRU_WIDTH), 0.01),
        'lru_conv_w': nrm(ks[14], (N_LRU, LRU_CONV, LRU_WIDTH), LRU_CONV ** -0.5),
        'lru_conv_b': nrm(ks[15], (N_LRU, LRU_WIDTH), 0.01),
        'lru_w_a': nrm(ks[16], (N_LRU, LRU_HEADS, LRU_HEAD_DIM, LRU_HEAD_DIM), LRU_HEAD_DIM ** -0.5),
        'lru_b_a': nrm(ks[17], (N_LRU, LRU_WIDTH), 0.01),
        'lru_w_i': nrm(ks[18], (N_LRU, LRU_HEADS, LRU_HEAD_DIM, LRU_HEAD_DIM), LRU_HEAD_DIM ** -0.5),
        'lru_b_i': nrm(ks[19], (N_LRU, LRU_WIDTH), 0.01),
        'lru_lambda': lam,
        'lru_w_out': nrm(ks[20], (N_LRU, LRU_WIDTH, D_MODEL), LRU_WIDTH ** -0.5),
        'lru_b_out': nrm(ks[21], (N_LRU, D_MODEL), 0.01),
        'attn_w_qkv': nrm(ks[22], (N_ATTN, D_MODEL, QKV_WIDTH), D_MODEL ** -0.5),
        'attn_w_o': nrm(ks[23], (N_ATTN, ATTN_WIDTH, D_MODEL), ATTN_WIDTH ** -0.5),
        'ffn_w_up': nrm(ks[24], (DEPTH, D_MODEL, 2 * D_FF), D_MODEL ** -0.5),
        'ffn_conv_w': nrm(ks[25], (DEPTH, FFN_CONV, 2 * D_FF), FFN_CONV ** -0.5),
        'ffn_conv_b': nrm(ks[26], (DEPTH, 2 * D_FF), 0.01),
        'ffn_w_down': nrm(ks[27], (DEPTH, D_FF, D_MODEL), D_FF ** -0.5),
    }


def reference(x_prompt, x_sample, cache_kv_w128, cache_kv_w512, cache_kv_w2048, state_lru_h, state_lru_conv, state_ffn_conv,
              norm_mix, norm_ffn, norm_final, lru_w_in, lru_b_in, lru_conv_w, lru_conv_b, lru_w_a, lru_b_a, lru_w_i, lru_b_i,
              lru_lambda, lru_w_out, lru_b_out, attn_w_qkv, attn_w_o, ffn_w_up, ffn_conv_w, ffn_conv_b, ffn_w_down):
    lru_p = (lru_w_in, lru_b_in, lru_conv_w, lru_conv_b, lru_w_a, lru_b_a, lru_w_i, lru_b_i, lru_lambda, lru_w_out, lru_b_out)
    attn_p = (attn_w_qkv, attn_w_o)
    ffn_p = (ffn_w_up, ffn_conv_w, ffn_conv_b, ffn_w_down)
    dt = x_prompt.dtype
    Bp = x_prompt.shape[0]
    y_p, h_p, lc_p, kv_p, fc_p = run_trunk(
        x_prompt,
        jnp.zeros((N_LRU, Bp, LRU_WIDTH), dt),
        jnp.zeros((N_LRU, Bp, LRU_CONV - 1, LRU_WIDTH), dt),
        None,
        jnp.zeros((DEPTH, Bp, FFN_CONV - 1, 2 * D_FF), dt),
        norm_mix, norm_ffn, norm_final, lru_p, attn_p, ffn_p)
    y_s, h_s, lc_s, kv_s, fc_s = run_trunk(
        x_sample, state_lru_h, state_lru_conv, (cache_kv_w128, cache_kv_w512, cache_kv_w2048), state_ffn_conv,
        norm_mix, norm_ffn, norm_final, lru_p, attn_p, ffn_p)
    return (y_p, y_s, kv_p[0], kv_p[1], kv_p[2], h_p, lc_p, fc_p, kv_s[0], kv_s[1], kv_s[2], h_s, lc_s, fc_s)
```

```cpp
#include <hip/hip_runtime.h>
#include <cstdio>
#include <cstdint>
#include <cmath>
namespace pg8 {
#define PG8_LAS __attribute__((address_space(3)))
typedef unsigned short bf16_t;
typedef PG8_LAS float* PG8_LAS_T;
typedef short bf16x8 __attribute__((ext_vector_type(8)));
typedef float f32x4 __attribute__((ext_vector_type(4)));
typedef unsigned u32x4 __attribute__((ext_vector_type(4)));
constexpr int BM = 256, BK = 64, HALF = 128, HTB = HALF * BK * 2  , STAGE_BYTES = 8 * HTB, NXCD = 8, WGM = 8;

__host__ __device__ __forceinline__ int lds_byte(int r, int c) { const int st = (r >> 4) * 2 + (c >> 5), rr = r & 15, cc = c & 31, ob = rr * 64 + cc * 2; return st * 1024 + (ob ^ (((ob >> 9) & 1) << 5)); }
__host__ __device__ __forceinline__ void stage_rc(int b, int& R, int& C) { const int st = b / 1024, sb = b % 1024, swz = sb ^ (((sb >> 9) & 1) << 5); R = (st >> 1) * 16 + swz / 64; C = (st & 1) * 32 + (swz % 64) / 2; }
__host__ __device__ __forceinline__ int perm32(int rho) { const int n = rho >> 4, i = rho & 15; return 8 * (i >> 2) + 4 * n + (i & 3); }

struct Unit { int pm, pn; };
struct Gemm { const bf16_t* A; const bf16_t* Bt; int M, N, K, lda, amod; };

struct GatesOrder {
    int G, c;
    __host__ __device__ void init(int G_, int c_) { G = G_; c = c_; }
    __host__ __device__ bool next(int i, Unit& u) const { const int P = (i >> 1) * G + c; if (P >= 256) return false; u.pm = P >> 3; u.pn = (P & 7) + 8 * (i & 1); return true; }
    __device__ __forceinline__ void a_ready(const Unit&) const {}
    __device__ __forceinline__ void done(const Unit&) const {}
};
struct StaticOrder {
    int nM, nN, nwg, G, c;
    __host__ __device__ void init(int M, int N, int G_, int c_) { nM = M / BM; nN = N / BM; nwg = nM * nN; G = G_; c = c_; }
    __host__ __device__ bool next(int i, Unit& u) const {
        const long L = (long)i * G + c; if (L >= nwg) return false;
        int wgid = (int)L; { const int q = nwg / NXCD, r = nwg % NXCD, xcd = wgid % NXCD, off = wgid / NXCD; wgid = (xcd < r ? xcd * (q + 1) : r * (q + 1) + (xcd - r) * q) + off; }
        const int nig = WGM * nN, gid = wgid / nig, fm = gid * WGM, gsz = (nM - fm) < WGM ? (nM - fm) : WGM;
        u.pm = fm + ((wgid % nig) % gsz); u.pn = (wgid % nig) / gsz; return true;
    }
    __device__ __forceinline__ void a_ready(const Unit&) const {}
    __device__ __forceinline__ void done(const Unit&) const {}
};


__device__ __forceinline__ unsigned cvt_pk_bf16(float lo, float hi) { unsigned r; asm volatile("v_cvt_pk_bf16_f32 %0, %1, %2" : "=v"(r) : "v"(lo), "v"(hi)); return r; }
__device__ __forceinline__ float gelu_tanh(float x) { const float t = x * (1.5957691216f + 0.0713548163f * x * x); return x * __builtin_amdgcn_rcpf(1.0f + __builtin_amdgcn_exp2f(-1.4426950409f * t)); }
__device__ __forceinline__ f32x4 gelu_tanh4(f32x4 x) { const f32x4 t = x * x; const f32x4 u = t * (-0.10294325f) + (-2.3022082f); const f32x4 z = x * u;
    f32x4 e; e[0] = __builtin_amdgcn_exp2f(z[0]); e[1] = __builtin_amdgcn_exp2f(z[1]); e[2] = __builtin_amdgcn_exp2f(z[2]); e[3] = __builtin_amdgcn_exp2f(z[3]);
    const f32x4 d = e + 1.0f; f32x4 r; r[0] = __builtin_amdgcn_rcpf(d[0]); r[1] = __builtin_amdgcn_rcpf(d[1]); r[2] = __builtin_amdgcn_rcpf(d[2]); r[3] = __builtin_amdgcn_rcpf(d[3]); return x * r; }
typedef float f32x2g __attribute__((ext_vector_type(2)));
__device__ __forceinline__ f32x2g gelu_tanh2(f32x2g x) { const f32x2g t = x * x; const f32x2g u = t * (-0.10294325f) + (-2.3022082f); const f32x2g z = x * u;
    f32x2g e; e[0] = __builtin_amdgcn_exp2f(z[0]); e[1] = __builtin_amdgcn_exp2f(z[1]); const f32x2g d = e + 1.0f; f32x2g r; r[0] = __builtin_amdgcn_rcpf(d[0]); r[1] = __builtin_amdgcn_rcpf(d[1]); return x * r; }
__device__ __forceinline__ float sigmoid_f(float x) { return __builtin_amdgcn_rcpf(1.0f + __builtin_amdgcn_exp2f(-1.4426950409f * x)); }
__device__ __forceinline__ float bf_lo(unsigned w) { return __uint_as_float(w << 16); }
__device__ __forceinline__ float bf_hi(unsigned w) { return __uint_as_float(w & 0xffff0000u); }
template <int O> __device__ __forceinline__ float xshf(float v) { return __int_as_float(__builtin_amdgcn_ds_swizzle(__float_as_int(v), (O << 10) | 0x1f)); }
__device__ __forceinline__ float half_sum(float v) { const auto rr = __builtin_amdgcn_permlane32_swap(__float_as_uint(v), __float_as_uint(v), false, false); return __uint_as_float(rr[0]) + __uint_as_float(rr[1]); }
__device__ __forceinline__ float half_max(float v) { const auto rr = __builtin_amdgcn_permlane32_swap(__float_as_uint(v), __float_as_uint(v), false, false); return fmaxf(__uint_as_float(rr[0]), __uint_as_float(rr[1])); }
__device__ __forceinline__ float rstd_ss(float ss) { return __builtin_amdgcn_rsqf(ss * (1.0f / 2048.0f) + 1e-6f); }
__device__ __forceinline__ float rstd_row8(const float* p) { const f32x4 a = *(const f32x4*)p, b = *(const f32x4*)(p + 4); return rstd_ss(((a[0] + a[1]) + (a[2] + a[3])) + ((b[0] + b[1]) + (b[2] + b[3]))); }

struct PreRow { f32x4 a; };
__device__ __forceinline__ void pre_row_load(PreRow& p, const float* SSP, int pm, int tid) { p.a = *(const f32x4*)(SSP + (size_t)(pm * BM + (tid & 255)) * 8 + 4 * (tid >> 8)); }
__device__ __forceinline__ void pre_row_publish(PG8_LAS float* L, const PreRow& p, int tid) {
    const int t = tid & 255, ai = t >> 7, wr = (t >> 6) & 1, m = (t >> 4) & 3, fr = t & 15;
    L[(tid >> 8) * 256 + (ai * 2 + wr) * 64 + 4 * fr + m] = (p.a[0] + p.a[1]) + (p.a[2] + p.a[3]); }
__device__ __forceinline__ f32x4 pre_row_read(const PG8_LAS float* L, int ai, int wr, int fr) {
    const f32x4 s0 = *(const PG8_LAS f32x4*)(L + (ai * 2 + wr) * 64 + 4 * fr), s1 = *(const PG8_LAS f32x4*)(L + 256 + (ai * 2 + wr) * 64 + 4 * fr);
    return (f32x4){rstd_ss(s0[0] + s1[0]), rstd_ss(s0[1] + s1[1]), rstd_ss(s0[2] + s1[2]), rstd_ss(s0[3] + s1[3])}; }
template <int MODE> struct EpiBf {
    static constexpr bool HAS_PRE = true;
    static constexpr bool PERM = true, PERMA = false, AFTER_DRAIN = false;
    struct Pre { PreRow r; float c; };
    __device__ __forceinline__ Pre prefetch(const Unit& u, int tid) const { Pre p; pre_row_load(p.r, SSP, u.pm, tid); p.c = (MODE == 1 && tid < 256) ? bias[u.pn * BM + tid] : 0.f; return p; }
    bf16_t* O; int ldc; const float* bias; bf16_t* O2; const float* SSP;
    __device__ __forceinline__ void operator()(const f32x4 (&acc)[2][2][4][2], const Unit& u, int wr, int wc, int fr, int fq, const Pre& pre, PG8_LAS unsigned char* lds, int tid) const {
        const int row0 = u.pm * BM + wr * 64 + fr; int colt = u.pn * BM; bf16_t* base = O; bool act = false;
        if (MODE == 1) { if (u.pn >= 8) { base = O2; colt -= 2048; } else act = true; }
        const int col0 = colt + wc * 32 + 8 * fq;
        PG8_LAS float* L = (PG8_LAS float*)(lds + 131072);
        pre_row_publish(L, pre.r, tid);
        if (MODE == 1 && tid < 256) L[512 + tid] = pre.c;
        asm volatile("s_waitcnt lgkmcnt(0)" ::: "memory"); __builtin_amdgcn_s_barrier(); asm volatile("" ::: "memory");
        f32x4 bv[2][2]; f32x4 rsv[2];
#pragma unroll
        for (int bj = 0; bj < 2; ++bj)
#pragma unroll
            for (int n = 0; n < 2; ++n) bv[bj][n] = (MODE == 1) ? *(const PG8_LAS f32x4*)(L + 512 + bj * HALF + wc * 32 + 8 * fq + 4 * n) : (f32x4){0.f, 0.f, 0.f, 0.f};
#pragma unroll
        for (int ai = 0; ai < 2; ++ai) rsv[ai] = pre_row_read(L, ai, wr, fr);
#pragma unroll
        for (int ai = 0; ai < 2; ++ai)
#pragma unroll
            for (int m = 0; m < 4; ++m) { bf16_t* rowp = base + (size_t)(row0 + ai * HALF + m * 16) * ldc + col0; const float rs = rsv[ai][m];
#pragma unroll
                for (int bj = 0; bj < 2; ++bj) { f32x4 v0 = acc[ai][bj][m][0] * rs + bv[bj][0], v1 = acc[ai][bj][m][1] * rs + bv[bj][1];
                    if (MODE == 1) { if (act) {
#pragma unroll
                        for (int e = 0; e < 1; ++e) { v0 = gelu_tanh4(v0); v1 = gelu_tanh4(v1); } } }
                    u32x4 w; w.x = cvt_pk_bf16(v0[0], v0[1]); w.y = cvt_pk_bf16(v0[2], v0[3]); w.z = cvt_pk_bf16(v1[0], v1[1]); w.w = cvt_pk_bf16(v1[2], v1[3]);
                    *(u32x4*)(rowp + bj * HALF) = w; } }
    }
};
struct EpiQkv {
    static constexpr bool HAS_PRE = true;
    static constexpr bool PERM = true, PERMA = false, AFTER_DRAIN = false;
    bf16_t* QP; const float* SSP;
    typedef PreRow Pre;
    __device__ __forceinline__ Pre prefetch(const Unit& u, int tid) const { Pre p; pre_row_load(p, SSP, u.pm, tid); return p; }
    __device__ __forceinline__ void operator()(const f32x4 (&acc)[2][2][4][2], const Unit& u, int wr, int wc, int fr, int fq, const Pre& pre, PG8_LAS unsigned char* lds, int tid) const {
        PG8_LAS float* L = (PG8_LAS float*)(lds + 131072);
        pre_row_publish(L, pre, tid);
        asm volatile("s_waitcnt lgkmcnt(0)" ::: "memory"); __builtin_amdgcn_s_barrier(); asm volatile("" ::: "memory");
        f32x4 rsv[2];
#pragma unroll
        for (int ai = 0; ai < 2; ++ai) rsv[ai] = pre_row_read(L, ai, wr, fr);
        const int g = u.pn / 12, part = (u.pn - g * 12) >> 2, h0 = (u.pn & 3) * 2;
        const int dsh = 2 * g, lsh = 12 - dsh;
        const int row0 = u.pm * BM + wr * 64 + fr, b = row0 >> 12;
        bf16_t* base = QP + ((size_t)((g * 3 + part) * 8 + h0) * 2 + b) * (4096 * 128) + wc * 32 + 8 * fq;
#pragma unroll
        for (int ai = 0; ai < 2; ++ai)
#pragma unroll
            for (int m = 0; m < 4; ++m) { const int row = row0 + ai * HALF + m * 16, t = row & 4095; const int pos = ((t & ((1 << dsh) - 1)) << lsh) + (t >> dsh);
                const float rs = rsv[ai][m];
#pragma unroll
                for (int bj = 0; bj < 2; ++bj) { const f32x4 v0 = acc[ai][bj][m][0] * rs, v1 = acc[ai][bj][m][1] * rs;
                    u32x4 w; w.x = cvt_pk_bf16(v0[0], v0[1]); w.y = cvt_pk_bf16(v0[2], v0[3]); w.z = cvt_pk_bf16(v1[0], v1[1]); w.w = cvt_pk_bf16(v1[2], v1[3]);
                    *(u32x4*)(base + (size_t)bj * (2 * 4096 * 128) + (size_t)pos * 128) = w; } }
    }
};
struct EpiGates {
    static constexpr bool HAS_PRE = false;
    static constexpr bool PERM = true, PERMA = false, AFTER_DRAIN = false;
    bf16_t* OMA; bf16_t* GI; const bf16_t* UC; const float* b_a; const float* b_i; const float* sp;
    __device__ __forceinline__ void operator()(const f32x4 (&acc)[2][2][4][2], const Unit& u, int wr, int wc, int fr, int fq) const {
        const int row0 = u.pm * BM + wr * 64 + fr; const bool isA = u.pn < 8; const int col0 = (u.pn & 7) * BM + wc * 32 + 8 * fq;
        const float* bsrc = isA ? b_a : b_i;
        f32x4 bv[2][2], sv[2][2];
#pragma unroll
        for (int bj = 0; bj < 2; ++bj)
#pragma unroll
            for (int n = 0; n < 2; ++n) { bv[bj][n] = *(const f32x4*)(bsrc + col0 + bj * HALF + 4 * n); sv[bj][n] = *(const f32x4*)(sp + col0 + bj * HALF + 4 * n) * (-8.0f * 1.4426950409f); }
#pragma unroll
        for (int ai = 0; ai < 2; ++ai)
#pragma unroll
            for (int m = 0; m < 4; ++m) { const size_t off = (size_t)(row0 + ai * HALF + m * 16) * 2048 + col0;
#pragma unroll
                for (int bj = 0; bj < 2; ++bj) { const f32x4 v0 = acc[ai][bj][m][0] + bv[bj][0], v1 = acc[ai][bj][m][1] + bv[bj][1]; float o[8];
                    if (isA) {
#pragma unroll
                        for (int e = 0; e < 4; ++e) { o[e] = 1.0f - __builtin_amdgcn_exp2f(sigmoid_f(v0[e]) * sv[bj][0][e]); o[4 + e] = 1.0f - __builtin_amdgcn_exp2f(sigmoid_f(v1[e]) * sv[bj][1][e]); }
                    } else {
                        const u32x4 uw = *(const u32x4*)(UC + off + bj * HALF);
                        o[0] = sigmoid_f(v0[0]) * bf_lo(uw.x); o[1] = sigmoid_f(v0[1]) * bf_hi(uw.x); o[2] = sigmoid_f(v0[2]) * bf_lo(uw.y); o[3] = sigmoid_f(v0[3]) * bf_hi(uw.y);
                        o[4] = sigmoid_f(v1[0]) * bf_lo(uw.z); o[5] = sigmoid_f(v1[1]) * bf_hi(uw.z); o[6] = sigmoid_f(v1[2]) * bf_lo(uw.w); o[7] = sigmoid_f(v1[3]) * bf_hi(uw.w);
                    }
                    u32x4 w; w.x = cvt_pk_bf16(o[0], o[1]); w.y = cvt_pk_bf16(o[2], o[3]); w.z = cvt_pk_bf16(o[4], o[5]); w.w = cvt_pk_bf16(o[6], o[7]);
                    if (isA) *(u32x4*)(OMA + off + bj * HALF) = w; else *(u32x4*)(GI + off + bj * HALF) = w; } }
    }
};
struct EpiResid {
    static constexpr bool HAS_PRE = true;
    struct Pre { float c; };
    __device__ __forceinline__ Pre prefetch(const Unit& u, int tid) const { Pre p; p.c = (bias && tid < 256) ? bias[u.pn * BM + tid] : 0.f; return p; }
    static constexpr bool PERM = true, PERMA = false, AFTER_DRAIN = false;
    bf16_t* XB; int ldc; const float* bias; float* SSP; PG8_LAS float* T;
    __device__ __forceinline__ void operator()(const f32x4 (&acc)[2][2][4][2], const Unit& u, int wr, int wc, int fr, int fq, const Pre& pre, PG8_LAS unsigned char* lds, int tid) const {
        const int row0 = u.pm * BM + wr * 64 + fr, col0 = u.pn * BM + wc * 32 + 8 * fq;
        PG8_LAS float* LB = (PG8_LAS float*)(lds + 131072 + 4096);
        if (tid < 256) LB[tid] = pre.c;
        asm volatile("s_waitcnt lgkmcnt(0)" ::: "memory"); __builtin_amdgcn_s_barrier(); asm volatile("" ::: "memory");
        const PG8_LAS float* lb = LB + wc * 32 + 8 * fq;
        u32x4 xin[2][4][2];
#pragma unroll
        for (int ai = 0; ai < 2; ++ai)
#pragma unroll
            for (int m = 0; m < 4; ++m)
#pragma unroll
                for (int bj = 0; bj < 2; ++bj) xin[ai][m][bj] = *(const u32x4*)(XB + (size_t)(row0 + ai * HALF + m * 16) * ldc + col0 + bj * HALF);
        __builtin_amdgcn_sched_barrier(0);
#pragma unroll
        for (int ai = 0; ai < 2; ++ai)
#pragma unroll
            for (int m = 0; m < 4; ++m) { const int row = row0 + ai * HALF + m * 16; const size_t off = (size_t)row * ldc + col0; float ss = 0.f;
#pragma unroll
                for (int bj = 0; bj < 2; ++bj) { const u32x4 xw = xin[ai][m][bj];
                    const f32x4 b0 = *(const PG8_LAS f32x4*)(lb + bj * HALF), b1 = *(const PG8_LAS f32x4*)(lb + bj * HALF + 4);
                    const f32x4 v0 = (f32x4){bf_lo(xw.x), bf_hi(xw.x), bf_lo(xw.y), bf_hi(xw.y)} + acc[ai][bj][m][0] + b0, v1 = (f32x4){bf_lo(xw.z), bf_hi(xw.z), bf_lo(xw.w), bf_hi(xw.w)} + acc[ai][bj][m][1] + b1;
                    u32x4 w; w.x = cvt_pk_bf16(v0[0], v0[1]); w.y = cvt_pk_bf16(v0[2], v0[3]); w.z = cvt_pk_bf16(v1[0], v1[1]); w.w = cvt_pk_bf16(v1[2], v1[3]);
                    *(u32x4*)(XB + off + bj * HALF) = w;
                    const float r0 = bf_lo(w.x), r1 = bf_hi(w.x), r2 = bf_lo(w.y), r3 = bf_hi(w.y), r4 = bf_lo(w.z), r5 = bf_hi(w.z), r6 = bf_lo(w.w), r7 = bf_hi(w.w);
                    ss += ((r0 * r0 + r1 * r1) + (r2 * r2 + r3 * r3)) + ((r4 * r4 + r5 * r5) + (r6 * r6 + r7 * r7)); }
                ss += xshf<16>(ss); ss = half_sum(ss);
                if (fq == 0) T[(ai * HALF + wr * 64 + m * 16 + fr) * 4 + wc] = ss; }
        asm volatile("s_waitcnt lgkmcnt(0)" ::: "memory"); __builtin_amdgcn_s_barrier(); asm volatile("" ::: "memory");
        if (tid < 256) { const f32x4 t = *(const PG8_LAS f32x4*)(T + tid * 4); SSP[(size_t)(u.pm * BM + tid) * 8 + u.pn] = (t[0] + t[1]) + (t[2] + t[3]); }
    }
};

__device__ __forceinline__ float dpp_shr1(float v) { return __builtin_bit_cast(float, __builtin_amdgcn_update_dpp(0, __builtin_bit_cast(int, v), 0x111, 0xf, 0xf, true)); }
struct EpiUpGlu {
    static constexpr bool PERM = true, PERMA = true, AFTER_DRAIN = false, HAS_PRE = true;
    bf16_t* ACT; bf16_t* HB; const float* cw; const float* cb; const float* SSP;
    struct Pre { f32x4 a, b; };
    __device__ __forceinline__ Pre prefetch(const Unit& u, int tid) const {
        Pre p;
        if (tid < 256) { const float* sp = SSP + (size_t)(u.pm * BM + tid) * 8; p.a = *(const f32x4*)sp; p.b = *(const f32x4*)(sp + 4); }
        else { const int i = tid - 256, arr = i >> 5, c4 = (i & 31) * 4; const int k = arr < 3 ? arr : arr - 3;
            const size_t off = (arr < 6 ? (size_t)k * 12288 : (size_t)0) + ((arr >= 3 && arr != 6) ? 6144 : 0) + (size_t)u.pn * 128 + c4;
            const float* base = arr < 6 ? cw : cb; p.a = *(const f32x4*)(base + off); p.b = p.a; }
        return p;
    }
    __device__ __forceinline__ void operator()(const f32x4 (&acc)[2][2][4][2], const Unit& u, int wr, int wc, int fr, int fq, const Pre& pre, PG8_LAS unsigned char* lds, int tid) const {
        const int gcol = u.pn * 128 + wc * 32 + 8 * fq;
        PG8_LAS float* L = (PG8_LAS float*)(lds + 131072);
        if (tid < 256) L[tid] = rstd_ss(((pre.a[0] + pre.a[1]) + (pre.a[2] + pre.a[3])) + ((pre.b[0] + pre.b[1]) + (pre.b[2] + pre.b[3])));
        else *(PG8_LAS f32x4*)(L + 256 + (tid - 256) * 4) = pre.a;
        asm volatile("s_waitcnt lgkmcnt(0)" ::: "memory"); __builtin_amdgcn_s_barrier(); asm volatile("" ::: "memory");
        float rs[2][4];
#pragma unroll
        for (int ai = 0; ai < 2; ++ai) { const f32x4 r = *(const PG8_LAS f32x4*)(L + (ai * 2 + wr) * 64 + 4 * fr);
#pragma unroll
            for (int m = 0; m < 4; ++m) rs[ai][m] = r[m]; }
        const PG8_LAS float* LW = L + 256 + wc * 32 + 8 * fq;
        if (fr == 0 || fr == 15) { const bool hi = fr == 15;
            typedef unsigned u32x2h __attribute__((ext_vector_type(2)));
#pragma unroll
            for (int ai = 0; ai < 2; ++ai) { const int slab = u.pm * 4 + ai * 2 + wr;
#pragma unroll
                for (int r = 0; r < 2; ++r) { const float rsel = hi ? rs[ai][2 + r] : rs[ai][r]; bf16_t* hp = HB + ((size_t)slab * 4 + (hi ? 2 + r : r)) * 12288 + gcol;
#pragma unroll
                    for (int n = 0; n < 2; ++n) { const f32x4 ga = acc[ai][0][r][n], gb = acc[ai][0][2 + r][n], va = acc[ai][1][r][n], vb = acc[ai][1][2 + r][n];
                        f32x4 gsel, vsel;
#pragma unroll
                        for (int q = 0; q < 4; ++q) { gsel[q] = (hi ? gb[q] : ga[q]) * rsel; vsel[q] = (hi ? vb[q] : va[q]) * rsel; }
                        u32x2h hg, hv; hg.x = cvt_pk_bf16(gsel[0], gsel[1]); hg.y = cvt_pk_bf16(gsel[2], gsel[3]); hv.x = cvt_pk_bf16(vsel[0], vsel[1]); hv.y = cvt_pk_bf16(vsel[2], vsel[3]);
                        *(u32x2h*)(hp + 4 * n) = hg; *(u32x2h*)(hp + 6144 + 4 * n) = hv; } } } }
        typedef unsigned u32x2 __attribute__((ext_vector_type(2)));
        u32x2 pk[2][4];
#pragma unroll
        for (int n = 0; n < 2; ++n) {
            f32x4 wg[3], wv[3];
#pragma unroll
            for (int k = 0; k < 3; ++k) { wg[k] = *(const PG8_LAS f32x4*)(LW + k * 128 + 4 * n); wv[k] = *(const PG8_LAS f32x4*)(LW + (3 + k) * 128 + 4 * n); }
            const f32x4 bg = *(const PG8_LAS f32x4*)(LW + 6 * 128 + 4 * n), bv = *(const PG8_LAS f32x4*)(LW + 7 * 128 + 4 * n);
#pragma unroll
            for (int ai = 0; ai < 2; ++ai) {
                const int slab = u.pm * 4 + ai * 2 + wr; const int row0 = slab * 64 + 4 * fr;
                f32x4 g1, g2, v1, v2;
                const f32x4 sg2 = acc[ai][0][2][n] * rs[ai][2], sg3 = acc[ai][0][3][n] * rs[ai][3], sv2 = acc[ai][1][2][n] * rs[ai][2], sv3 = acc[ai][1][3][n] * rs[ai][3];
#pragma unroll
                for (int e = 0; e < 4; ++e) { g1[e] = dpp_shr1(sg3[e]); g2[e] = dpp_shr1(sg2[e]); v1[e] = dpp_shr1(sv3[e]); v2[e] = dpp_shr1(sv2[e]); }
#pragma unroll
                for (int m = 0; m < 4; ++m) { const f32x4 gc = m == 2 ? sg2 : (m == 3 ? sg3 : acc[ai][0][m][n] * rs[ai][m]), vc = m == 2 ? sv2 : (m == 3 ? sv3 : acc[ai][1][m][n] * rs[ai][m]);
                    const f32x4 cg = bg + wg[0] * g2 + wg[1] * g1 + wg[2] * gc, cv = bv + wv[0] * v2 + wv[1] * v1 + wv[2] * vc;
                    const f32x4 gl = gelu_tanh4(cg) * cv; u32x2 o; o.x = cvt_pk_bf16(gl[0], gl[1]); o.y = cvt_pk_bf16(gl[2], gl[3]);
                    if (n == 0) pk[ai][m] = o;
                    else if (!(fr == 0 && m < 2)) { u32x4 w; w.x = pk[ai][m].x; w.y = pk[ai][m].y; w.z = o.x; w.w = o.y; *(u32x4*)(ACT + (size_t)(row0 + m) * 6144 + gcol) = w; }
                    g2 = g1; g1 = gc; v2 = v1; v1 = vc; }
            }
        }
    }
};

struct EpiNull {
    static constexpr bool HAS_PRE = false;
    static constexpr bool PERM = true, PERMA = true, AFTER_DRAIN = false;
    float* sink;
    __device__ __forceinline__ void operator()(const f32x4 (&acc)[2][2][4][2], const Unit& u, int wr, int wc, int fr, int fq) const {
        float s = 0.f;
#pragma unroll
        for (int ai = 0; ai < 2; ++ai)
#pragma unroll
            for (int bj = 0; bj < 2; ++bj)
#pragma unroll
                for (int m = 0; m < 4; ++m)
#pragma unroll
                    for (int n = 0; n < 2; ++n) s += acc[ai][bj][m][n][0] + acc[ai][bj][m][n][1] + acc[ai][bj][m][n][2] + acc[ai][bj][m][n][3];
        if (s == 12345.678f) sink[u.pm] = s;
    }
};

struct NoPreT {};
template <class Epi, bool H> struct PreOf { typedef NoPreT type; };
template <class Epi> struct PreOf<Epi, true> { typedef typename Epi::Pre type; };
template <class Epi, class Sched, bool ALIGN_EPI = false, bool SP2 = false>
__device__ __forceinline__ void gemm_phase(PG8_LAS unsigned char* lds, const Gemm g, const Sched& S, const Epi& E, const int wv) {
    int lane; asm volatile("v_mbcnt_lo_u32_b32 %0, -1, 0\n\tv_mbcnt_hi_u32_b32 %0, -1, %0" : "=v"(lane)); const int wid = wv, tid = wv * 64 + lane, wr = wid >> 2, wc = wid & 3, fr = lane & 15, fq = lane >> 4;
    int K_ = g.K; asm volatile("" : "+s"(K_)); const int K = K_, nt = K / BK;
    unsigned voffA[2], voffB[2];
#pragma unroll
    for (int i = 0; i < 2; ++i) { int R, C; stage_rc(tid * 16 + i * 8192, R, C); const int Rb = Epi::PERM ? ((R & ~31) + perm32(R & 31)) : R;
        const int Ra = Epi::PERMA ? ((R & ~63) + 4 * (R & 15) + ((R >> 4) & 3)) : R;
        voffA[i] = (unsigned)(Ra * g.lda + C) * 2u; voffB[i] = (unsigned)(Rb * K + C) * 2u; }
    const size_t kstep = (size_t)(BK * 2);
    const size_t hstepB = (size_t)HALF * K * 2, hstepA = (size_t)HALF * g.lda * 2;
    const size_t tstepA = 2 * hstepA, tstepB = 2 * hstepB;
    const unsigned ldsw = (unsigned)wid * 1024u;
    const int aoff = lds_byte(wr * 64 + fr, fq * 8), boff = lds_byte(wc * 32 + fr, fq * 8);
#define PG8_SA(b, h) (((b) * 2 + (h)) * HTB)
#define PG8_SB(b, h) ((4 + (b) * 2 + (h)) * HTB)
#define PG8_STAGE(bufoff, gbase, voff) do { _Pragma("unroll") for (int _i = 0; _i < 2; ++_i) \
        __builtin_amdgcn_global_load_lds((const unsigned*)((const char*)(gbase) + (voff)[_i]), (PG8_LAS unsigned*)(lds + (bufoff) + ldsw + _i * 8192), 16, 0, 0); } while (0)
#define PG8_LDA(dst, b, h) do { _Pragma("unroll") for (int m = 0; m < 4; ++m) _Pragma("unroll") for (int k = 0; k < 2; ++k) dst[m][k] = *(const PG8_LAS bf16x8*)(lds + PG8_SA(b, h) + aoff + m * 2048 + k * 1024); } while (0)
#define PG8_LDB(dst, b, h) do { _Pragma("unroll") for (int n = 0; n < 2; ++n) _Pragma("unroll") for (int k = 0; k < 2; ++k) dst[n][k] = *(const PG8_LAS bf16x8*)(lds + PG8_SB(b, h) + boff + n * 2048 + k * 1024); } while (0)
#define PG8_MMA(ai, bj, At, Bt) do { __builtin_amdgcn_s_setprio(1); _Pragma("unroll") for (int m = 0; m < 4; ++m) _Pragma("unroll") for (int n = 0; n < 2; ++n) _Pragma("unroll") for (int k = 0; k < 2; ++k) \
        acc[ai][bj][m][n] = __builtin_amdgcn_mfma_f32_16x16x32_bf16(Bt[n][k], At[m][k], acc[ai][bj][m][n], 0, 0, 0); __builtin_amdgcn_s_setprio(0); } while (0)
#define PG8_WAIT_V(n) asm volatile("s_waitcnt vmcnt(" #n ")" ::: "memory")
#define PG8_WAIT_L(n) asm volatile("s_waitcnt lgkmcnt(" #n ")" ::: "memory")
#define PG8_BAR __builtin_amdgcn_s_barrier()
#define PG8_SCHED __builtin_amdgcn_sched_barrier(0)
    Unit cur, nxt; int ui = 0;
    if (!S.next(0, cur)) return;
    f32x4 acc[2][2][4][2];
#pragma unroll
    for (int a = 0; a < 2; ++a)
#pragma unroll
        for (int b = 0; b < 2; ++b)
#pragma unroll
            for (int m = 0; m < 4; ++m)
#pragma unroll
                for (int n = 0; n < 2; ++n) acc[a][b][m][n] = (f32x4){0.f, 0.f, 0.f, 0.f};
    bf16x8 At[4][2], B0[2][2], B1[2][2];
    const char* cA = (const char*)g.A + (size_t)cur.pm * tstepA + (g.amod ? (size_t)(cur.pn % g.amod) * K * 2 : (size_t)0); const char* cB = (const char*)g.Bt + (size_t)cur.pn * tstepB;
    S.a_ready(cur);
    typename PreOf<Epi, Epi::HAS_PRE>::type pre; if constexpr (Epi::HAS_PRE) pre = E.prefetch(cur, tid);
    if constexpr (SP2) {
        PG8_STAGE(PG8_SB(0, 0), cB, voffB); PG8_STAGE(PG8_SB(0, 1), cB + hstepB, voffB); PG8_STAGE(PG8_SA(0, 0), cA, voffA); PG8_STAGE(PG8_SA(0, 1), cA + hstepA, voffA);
        if (wr == 1) PG8_BAR;
        PG8_WAIT_V(2); PG8_BAR;
        PG8_STAGE(PG8_SB(1, 0), cB + kstep, voffB); PG8_STAGE(PG8_SA(1, 0), cA + kstep, voffA); PG8_STAGE(PG8_SB(1, 1), cB + hstepB + kstep, voffB);
        PG8_WAIT_V(6); PG8_BAR;
    } else {
        PG8_STAGE(PG8_SB(0, 0), cB, voffB); PG8_STAGE(PG8_SA(0, 0), cA, voffA); PG8_STAGE(PG8_SB(0, 1), cB + hstepB, voffB); PG8_STAGE(PG8_SA(0, 1), cA + hstepA, voffA);
        if (wr == 1) PG8_BAR;
        PG8_WAIT_V(4); PG8_BAR;
        PG8_STAGE(PG8_SB(1, 0), cB + kstep, voffB); PG8_STAGE(PG8_SA(1, 0), cA + kstep, voffA); PG8_STAGE(PG8_SB(1, 1), cB + hstepB + kstep, voffB);
        PG8_WAIT_V(6); PG8_BAR;
    }
    for (;;) {
        const bool has_next = S.next(ui + 1, nxt);
        const char* nA = has_next ? (const char*)g.A + (size_t)nxt.pm * tstepA + (g.amod ? (size_t)(nxt.pn % g.amod) * K * 2 : (size_t)0) : cA; const char* nB = has_next ? (const char*)g.Bt + (size_t)nxt.pn * tstepB : cB;
        for (int t = 0; t < nt; t += 2) {
            const bool last = (t == nt - 2);
            const char* a1 = cA + (size_t)(t + 1) * kstep;
            const char* a2 = last ? nA : cA + (size_t)(t + 2) * kstep; const char* b2 = last ? nB : cB + (size_t)(t + 2) * kstep;
            const char* a3 = a2 + kstep; const char* b3 = b2 + kstep;
            if (last && has_next) S.a_ready(nxt);
            if constexpr (SP2) {
            PG8_LDB(B0, 0, 0); PG8_LDB(B1, 0, 1); PG8_SCHED; PG8_LDA(At, 0, 0); PG8_STAGE(PG8_SA(1, 1), a1 + hstepA, voffA);
            PG8_WAIT_V(8); PG8_WAIT_L(0); PG8_BAR; PG8_MMA(0, 0, At, B0); PG8_MMA(0, 1, At, B1); PG8_BAR; PG8_SCHED;
            PG8_LDA(At, 0, 1); PG8_STAGE(PG8_SB(0, 0), b2, voffB); PG8_STAGE(PG8_SB(0, 1), b2 + hstepB, voffB); PG8_STAGE(PG8_SA(0, 0), a2, voffA);
            PG8_WAIT_V(8); PG8_WAIT_L(0); PG8_BAR; PG8_MMA(1, 0, At, B0); PG8_MMA(1, 1, At, B1); PG8_BAR; PG8_SCHED;
            PG8_LDB(B0, 1, 0); PG8_LDB(B1, 1, 1); PG8_SCHED; PG8_LDA(At, 1, 0); PG8_STAGE(PG8_SA(0, 1), a2 + hstepA, voffA);
            PG8_WAIT_V(8); PG8_WAIT_L(0); PG8_BAR; PG8_MMA(0, 0, At, B0); PG8_MMA(0, 1, At, B1); PG8_BAR; PG8_SCHED;
            PG8_LDA(At, 1, 1); PG8_STAGE(PG8_SB(1, 0), b3, voffB); PG8_STAGE(PG8_SB(1, 1), b3 + hstepB, voffB); PG8_STAGE(PG8_SA(1, 0), a3, voffA);
            PG8_WAIT_V(8); PG8_WAIT_L(0); PG8_BAR; PG8_MMA(1, 0, At, B0); PG8_MMA(1, 1, At, B1); PG8_BAR; PG8_SCHED;
            } else {
            PG8_LDB(B0, 0, 0); PG8_SCHED; PG8_LDA(At, 0, 0); PG8_STAGE(PG8_SA(1, 1), a1 + hstepA, voffA);
            PG8_WAIT_L(8); PG8_BAR; PG8_WAIT_L(0); PG8_MMA(0, 0, At, B0); PG8_BAR; PG8_SCHED;
            PG8_LDB(B1, 0, 1); PG8_STAGE(PG8_SB(0, 0), b2, voffB);
            PG8_BAR; PG8_WAIT_L(0); PG8_MMA(0, 1, At, B1); PG8_BAR;
            PG8_LDA(At, 0, 1); PG8_STAGE(PG8_SA(0, 0), a2, voffA);
            PG8_BAR; PG8_WAIT_L(0); PG8_MMA(1, 0, At, B0); PG8_BAR; PG8_SCHED;
            PG8_STAGE(PG8_SB(0, 1), b2 + hstepB, voffB);
            PG8_WAIT_V(6); PG8_BAR; PG8_MMA(1, 1, At, B1); PG8_BAR;
            PG8_LDB(B0, 1, 0); PG8_SCHED; PG8_LDA(At, 1, 0); PG8_STAGE(PG8_SA(0, 1), a2 + hstepA, voffA);
            PG8_WAIT_L(8); PG8_BAR; PG8_WAIT_L(0); PG8_MMA(0, 0, At, B0); PG8_BAR; PG8_SCHED;
            PG8_LDB(B1, 1, 1); PG8_STAGE(PG8_SB(1, 0), b3, voffB);
            PG8_BAR; PG8_WAIT_L(0); PG8_MMA(0, 1, At, B1); PG8_BAR;
            PG8_LDA(At, 1, 1); PG8_STAGE(PG8_SA(1, 0), a3, voffA);
            PG8_BAR; PG8_WAIT_L(0); PG8_MMA(1, 0, At, B0); PG8_BAR; PG8_SCHED;
            PG8_STAGE(PG8_SB(1, 1), b3 + hstepB, voffB);
            PG8_WAIT_V(6); PG8_BAR; PG8_MMA(1, 1, At, B1); PG8_BAR;
            }
        }
        if constexpr (ALIGN_EPI) { if (wr == 0) PG8_BAR; }
        if constexpr (!Epi::AFTER_DRAIN) { if constexpr (Epi::HAS_PRE) E(acc, cur, wr, wc, fr, fq, pre, lds, tid); else E(acc, cur, wr, wc, fr, fq); S.done(cur); }
        if (!has_next) break;
#pragma unroll
        for (int a = 0; a < 2; ++a)
#pragma unroll
            for (int b = 0; b < 2; ++b)
#pragma unroll
                for (int m = 0; m < 4; ++m)
#pragma unroll
                    for (int n = 0; n < 2; ++n) acc[a][b][m][n] = (f32x4){0.f, 0.f, 0.f, 0.f};
        cur = nxt; cA = nA; cB = nB; ++ui;
        if constexpr (Epi::HAS_PRE) pre = E.prefetch(cur, tid);
        if constexpr (ALIGN_EPI) { if (wr == 1) PG8_BAR; }
    }
    PG8_WAIT_V(0);
    if constexpr (!ALIGN_EPI) { if (wr == 0) PG8_BAR; }
    PG8_BAR;
    if constexpr (Epi::AFTER_DRAIN) { E.fused(acc, cur, wr, wc, fr, fq, lds, wid, lane); S.done(cur); }
#undef PG8_SA
#undef PG8_SB
#undef PG8_STAGE
#undef PG8_LDA
#undef PG8_LDB
#undef PG8_MMA
#undef PG8_WAIT_V
#undef PG8_WAIT_L
#undef PG8_BAR
#undef PG8_SCHED
}
}

#ifndef PG8_SP2
#define PG8_SP2 true
#endif
#ifndef PG8_ALIGN
#define PG8_ALIGN true
#endif

constexpr int NWAVES = 8, NTHR = 512;
constexpr int DM = 2048, TSEQ = 4096, NBATCH = 2, MP = NBATCH * TSEQ, SB = 8, ST = 4, MS = SB * ST, MT = MP + MS, DEPTH = 4;
constexpr int NQKV = 9216, AW = 1024, FF2 = 12288, FF = 6144;
constexpr float RMS_EPS = 1e-6f;
enum { I_XP = 0, I_XS, I_C128, I_C512, I_C2048, I_SLH, I_SLC, I_SFC, I_NMIX, I_NFFN, I_NFIN, I_LWIN, I_LBIN, I_LCW, I_LCB, I_LWA, I_LBA, I_LWI, I_LBI, I_LLAM, I_LWOUT, I_LBOUT, I_AWQKV, I_AWO, I_FWUP, I_FCW, I_FCB, I_FWDN, N_IN };
constexpr size_t O_YP = 0, O_YS = O_YP + (size_t)MP * DM, O_KVP0 = O_YS + (size_t)MS * DM, O_KVP1 = O_KVP0 + (size_t)2 * 2 * 128 * 2048, O_KVP2 = O_KVP1 + (size_t)2 * 2 * 512 * 2048,
                 O_LHP = O_KVP2 + (size_t)2 * 2 * 2048 * 2048, O_LCP = O_LHP + (size_t)2 * 2 * 2048, O_FCP = O_LCP + (size_t)2 * 2 * 3 * 2048, O_KVS0 = O_FCP + (size_t)4 * 2 * 2 * FF2,
                 O_KVS1 = O_KVS0 + (size_t)2 * 8 * 4 * 2048, O_KVS2 = O_KVS1 + (size_t)2 * 8 * 4 * 2048, O_LHS = O_KVS2 + (size_t)2 * 8 * 4 * 2048, O_LCS = O_LHS + (size_t)2 * 8 * 2048,
                 O_FCS = O_LCS + (size_t)2 * 8 * 3 * 2048, O_END = O_FCS + (size_t)4 * 8 * 2 * FF2;
static_assert(O_END == 40402944, "output size");

constexpr size_t MiB = 1u << 20;
constexpr size_t WS_CTL = 0, CTL_ZERO_BYTES = 32 * 1024;
constexpr size_t WS_MISC = 1 * MiB;
constexpr size_t WS_WIN = 2 * MiB;
constexpr size_t WS_WOUT = WS_WIN + 32 * MiB;
constexpr size_t WS_GT = WS_WOUT + 16 * MiB;
constexpr size_t WS_WQKV = WS_GT + 4 * MiB;
constexpr size_t WS_WO = WS_WQKV + 72 * MiB;
constexpr size_t WS_WUP = WS_WO + 8 * MiB;
constexpr size_t WS_WDN = WS_WUP + 192 * MiB;
constexpr size_t WS_X = WS_WDN + 96 * MiB;
constexpr size_t WS_XN = WS_X + 65 * MiB;
constexpr size_t WS_SC = WS_XN + 33 * MiB;
constexpr size_t WS_S = WS_SC + 3 * MiB;
constexpr size_t S_GG = 0, S_U = 33 * MiB, S_UC = 66 * MiB, S_HG = 99 * MiB, S_LA = 132 * MiB, S_GI = 197 * MiB;
constexpr size_t S_QKV = 0, S_OG = 145 * MiB, S_LSE = 242 * MiB, S_O = 243 * MiB;
constexpr size_t S_UPS = 0, S_HB = 1 * MiB, S_ACT = 193 * MiB;
constexpr size_t WS_SSP = WS_S + 290 * MiB;
constexpr size_t WS_SSS = WS_SSP + 3 * MiB;
constexpr size_t WS_END = WS_SSS + 1 * MiB;
static_assert((size_t)MT * NQKV * 2 <= 145 * MiB && (size_t)3 * MT * AW * 4 <= 97 * MiB && (size_t)MT * FF * 2 <= 97 * MiB && (size_t)MT * DM * 4 <= 65 * MiB && (size_t)MT * DM * 2 <= 33 * MiB, "d_ws map");
constexpr int CW_TMO = 0, CW_CODE = 1, CW_BAR = 4096;
static_assert((size_t)(CW_BAR + 3456) * 4 <= CTL_ZERO_BYTES, "barrier words inside the per-call memset");

constexpr int RING_OFF = 0, RING_BYTES = 147456;
constexpr int LDSCTL_OFF = RING_BYTES, MISC_OFF = LDSCTL_OFF + 320;
constexpr int LDS_BYTES = 148480;
constexpr int EPI_T_OFF = 131072;
static_assert(MISC_OFF + 128 <= LDS_BYTES, "LDS map");

#define GAS __attribute__((address_space(1)))
#define LAS __attribute__((address_space(3)))
typedef unsigned short bf16;
typedef unsigned v4u __attribute__((ext_vector_type(4)));
typedef unsigned v2u __attribute__((ext_vector_type(2)));
typedef float f32x4 __attribute__((ext_vector_type(4)));
typedef float f32x2 __attribute__((ext_vector_type(2)));
typedef short bf16x8 __attribute__((ext_vector_type(8)));
typedef GAS unsigned gu32;
#define RLX_AGENT __ATOMIC_RELAXED, __HIP_MEMORY_SCOPE_AGENT
#define LDS_WAIT() asm volatile("s_waitcnt lgkmcnt(0)" ::: "memory")
#define VM_WAIT() asm volatile("s_waitcnt vmcnt(0)" ::: "memory")
using pg8::cvt_pk_bf16; using pg8::gelu_tanh; using pg8::sigmoid_f; using pg8::bf_lo; using pg8::bf_hi;
__device__ __forceinline__ bf16 f2bf1(float f) { return (bf16)(cvt_pk_bf16(f, 0.f) & 0xffffu); }
__device__ __forceinline__ float bf2f(bf16 b) { return __uint_as_float((unsigned)b << 16); }
__device__ __forceinline__ void unpack8(const v4u w, float (&f)[8]) { f[0] = bf_lo(w.x); f[1] = bf_hi(w.x); f[2] = bf_lo(w.y); f[3] = bf_hi(w.y); f[4] = bf_lo(w.z); f[5] = bf_hi(w.z); f[6] = bf_lo(w.w); f[7] = bf_hi(w.w); }
__device__ __forceinline__ v4u pack8(const float (&f)[8]) { v4u w; w.x = cvt_pk_bf16(f[0], f[1]); w.y = cvt_pk_bf16(f[2], f[3]); w.z = cvt_pk_bf16(f[4], f[5]); w.w = cvt_pk_bf16(f[6], f[7]); return w; }
__device__ __forceinline__ void load8f(const float* p, float (&f)[8]) { const f32x4 a = *(const f32x4*)p, b = *(const f32x4*)(p + 4); f[0] = a[0]; f[1] = a[1]; f[2] = a[2]; f[3] = a[3]; f[4] = b[0]; f[5] = b[1]; f[6] = b[2]; f[7] = b[3]; }
__device__ __forceinline__ void store8f(float* p, const float (&f)[8]) { *(f32x4*)p = (f32x4){f[0], f[1], f[2], f[3]}; *(f32x4*)(p + 4) = (f32x4){f[4], f[5], f[6], f[7]}; }
using pg8::xshf; using pg8::half_sum; using pg8::half_max; using pg8::rstd_ss; using pg8::rstd_row8;
__device__ __forceinline__ float wave_sum(float v) { v += xshf<1>(v); v += xshf<2>(v); v += xshf<4>(v); v += xshf<8>(v); v += xshf<16>(v); return half_sum(v); }
__device__ __forceinline__ float wave_max(float v) { v = fmaxf(v, xshf<1>(v)); v = fmaxf(v, xshf<2>(v)); v = fmaxf(v, xshf<4>(v)); v = fmaxf(v, xshf<8>(v)); v = fmaxf(v, xshf<16>(v)); return half_max(v); }
__device__ __forceinline__ int lane_id() { int l; asm volatile("v_mbcnt_lo_u32_b32 %0, -1, 0\n\tv_mbcnt_hi_u32_b32 %0, -1, %0" : "=v"(l)); return l; }
#define XB_TMO      128
#define XB_XCNT(j)  (256  + 64 * (j))
#define XB_XSUB(j)  (1280 + 64 * (j))
#define XB_XGEN(j)  (2304 + 64 * (j))
#define XB_TOP      3328
#define XB_TOPGEN   3392
#define XCD_BAR_WORDS 3456
#define XB_SPIN_CAP (1u << 18)

__device__ __forceinline__ unsigned xb_ld(unsigned* p)              { return __hip_atomic_load(p, __ATOMIC_RELAXED, __HIP_MEMORY_SCOPE_AGENT); }
__device__ __forceinline__ unsigned xb_add(unsigned* p, unsigned v) { return __hip_atomic_fetch_add(p, v, __ATOMIC_RELAXED, __HIP_MEMORY_SCOPE_AGENT); }
__device__ __forceinline__ unsigned xb_xcc_id() { return (unsigned)__builtin_amdgcn_s_getreg((3 << 11) | 20) & 0xFu; }
#define XB_SPIN(cond, bar) do { unsigned _sp = 0; while (cond) { __builtin_amdgcn_s_sleep(1); \
    if ((++_sp & 255u) == 0u) { if (xb_ld(&(bar)[XB_TMO])) break; if (_sp > XB_SPIN_CAP) { atomicAdd(&(bar)[XB_TMO], 1u); break; } } } } while (0)

struct XcdBarrier {
    unsigned* bar; unsigned x; int wv;
    volatile LAS unsigned* st;
};

__device__ __forceinline__ bool xb_thread0(int wv) { return wv == 0 && lane_id() == 0; }
__device__ __forceinline__ XcdBarrier xcd_barrier_post(unsigned* bar, volatile LAS unsigned* st, int wv) {
    XcdBarrier b; b.bar = bar; b.x = xb_xcc_id(); b.st = st; b.wv = wv;
    if (xb_thread0(wv)) (void)xb_add(&bar[XB_XCNT(b.x)], 1u);
    return b;
}
__device__ __forceinline__ void xcd_barrier_complete(unsigned* bar, unsigned x, unsigned& nloc, unsigned& nx) {
    const unsigned G = gridDim.x * gridDim.y * gridDim.z;
    unsigned sum, cnt, mine, sp = 0u;
    for (;;) {
        sum = 0u; cnt = 0u; mine = 0u;
#pragma unroll
        for (unsigned j = 0; j < 16; ++j) { const unsigned c = xb_ld(&bar[XB_XCNT(j)]); sum += c; cnt += (c > 0u) ? 1u : 0u; mine = (j == x) ? c : mine; }
        if (sum == G) break;
        __builtin_amdgcn_s_sleep(1);
        if ((++sp & 255u) == 0u) { if (xb_ld(&bar[XB_TMO])) break; if (sp > XB_SPIN_CAP) { atomicAdd(&bar[XB_TMO], 1u); break; } }
    }
    nloc = mine > 0u ? mine : 1u; nx = cnt > 0u ? cnt : 1u;
}

__device__ __forceinline__ void xcd_barrier(const XcdBarrier& b) {
    asm volatile("s_waitcnt vmcnt(0)" ::: "memory");
    __syncthreads();
    if (xb_thread0(b.wv)) {
        unsigned* bar = b.bar;
        __builtin_amdgcn_s_waitcnt(0);
        unsigned nloc = b.st[0], nx = b.st[1];
        if (nloc == 0u) { xcd_barrier_complete(bar, b.x, nloc, nx); b.st[0] = nloc; b.st[1] = nx; }
        const unsigned old = xb_add(&bar[XB_XSUB(b.x)], 1u);
        const unsigned gen = old / nloc;
        if (old + 1u == (gen + 1u) * nloc) {
            __builtin_amdgcn_fence(__ATOMIC_RELEASE, "agent");
            asm volatile("s_waitcnt vmcnt(0)" ::: "memory");
            const unsigned og = xb_add(&bar[XB_TOP], 1u);
            const unsigned tg = og / nx;
            if (og + 1u == (tg + 1u) * nx) xb_add(&bar[XB_TOPGEN], 1u);
            else XB_SPIN(xb_ld(&bar[XB_TOPGEN]) == tg, bar);
            __builtin_amdgcn_fence(__ATOMIC_ACQUIRE, "agent");
            xb_add(&bar[XB_XGEN(b.x)], 1u);
            asm volatile("s_waitcnt vmcnt(0)" ::: "memory");
        } else {
            XB_SPIN(xb_ld(&bar[XB_XGEN(b.x)]) == gen, bar);
            __builtin_amdgcn_fence(__ATOMIC_ACQUIRE, "agent");
            asm volatile("s_waitcnt vmcnt(0)" ::: "memory");
        }
    }
    __syncthreads();
}

struct Args { const float* in[N_IN]; float* out; unsigned char* ws; };
typedef __attribute__((address_space(4))) const Args CArgs;
__device__ __forceinline__ CArgs* kargs() { CArgs* p = (CArgs*)__builtin_amdgcn_kernarg_segment_ptr(); asm volatile("" : "+s"(p)); return p; }
struct Frame {
    LAS unsigned char* lds;
    int tid, lane, wave, G, bx;
    int gw, ngw, gt, ngt;
};

__device__ __forceinline__ Frame mk_frame(LAS unsigned char* lds, int wv) {
    Frame F; asm volatile("" : "+s"(wv)); const int lane = lane_id(); const int tid = wv * 64 + lane;
    F.lds = lds; F.tid = tid; F.lane = lane; F.wave = wv;
    int G_ = gridDim.x, bx_ = blockIdx.x; asm volatile("" : "+s"(G_), "+s"(bx_)); F.G = G_; F.bx = bx_;
    F.gw = F.bx * NWAVES + F.wave; F.ngw = F.G * NWAVES; F.gt = F.bx * NTHR + tid; F.ngt = F.G * NTHR;
    return F;
}

template <int GLU = 0>
__device__ __forceinline__ void p0_transpose_item(const float* W, int K, int N, bf16* WT, LAS float* scr, int item, int lane, const float* gain = nullptr) {
    const int nblk = N / 32, kb = item / nblk, nb = item % nblk, k0 = 128 * kb, n0 = 32 * nb;
    const int nd0 = GLU ? (n0 < 6144 ? 256 * (n0 >> 7) + (n0 & 127) : 256 * ((n0 - 6144) >> 7) + 128 + ((n0 - 6144) & 127)) : n0;
#pragma unroll 32
    for (int i = 0; i < 64; ++i) { const int kk = 2 * i + (lane >> 5); scr[kk * 33 + (lane & 31)] = W[(size_t)(k0 + kk) * N + n0 + (lane & 31)]; }
    LDS_WAIT(); asm volatile("" ::: "memory");
    const int c = lane & 15;
    float gk[8];
    if (gain) load8f(gain + k0 + 8 * c, gk); else {
#pragma unroll
        for (int e = 0; e < 8; ++e) gk[e] = 1.0f; }
#pragma unroll
    for (int j = 0; j < 8; ++j) { const int n = (lane >> 4) + 4 * j; const LAS float* s = scr + (8 * c) * 33 + n;
        v4u o; o.x = cvt_pk_bf16(s[0 * 33] * gk[0], s[1 * 33] * gk[1]); o.y = cvt_pk_bf16(s[2 * 33] * gk[2], s[3 * 33] * gk[3]); o.z = cvt_pk_bf16(s[4 * 33] * gk[4], s[5 * 33] * gk[5]); o.w = cvt_pk_bf16(s[6 * 33] * gk[6], s[7 * 33] * gk[7]);
        *(GAS v4u*)(WT + (size_t)(nd0 + n) * K + k0 + 8 * c) = o; }
    LDS_WAIT(); asm volatile("" ::: "memory");
}
__device__ __forceinline__ void rows_to_bf16_ss(const Frame& F, const float* xp, const float* xs, bf16* XB, float* SSP, float* SSS) {
#pragma unroll 2
    for (int m = F.gw; m < MT; m += F.ngw) {
        const float* src = (m < MP) ? xp + (size_t)m * DM : xs + (size_t)(m - MP) * DM;
        const GAS f32x4* xr = (const GAS f32x4*)src + F.lane;
        f32x4 v[8]; float s = 0.f;
#pragma unroll
        for (int j = 0; j < 8; ++j) { v[j] = xr[64 * j]; s += (v[j].x * v[j].x + v[j].y * v[j].y) + (v[j].z * v[j].z + v[j].w * v[j].w); }
        s = wave_sum(s);
        GAS v2u* o8 = (GAS v2u*)(XB + (size_t)m * DM) + F.lane;
#pragma unroll
        for (int j = 0; j < 8; ++j) { v2u w; w.x = cvt_pk_bf16(v[j].x, v[j].y); w.y = cvt_pk_bf16(v[j].z, v[j].w); o8[64 * j] = w; }
        if (m < MP) { if (F.lane < 8) SSP[(size_t)m * 8 + F.lane] = F.lane == 0 ? s : 0.f; } else { *(f32x2*)(SSS + (size_t)(m - MP) * 128 + 2 * F.lane) = (f32x2){F.lane == 0 ? s : 0.f, 0.f}; }
    }
}
__device__ __forceinline__ void norm_rows_out(const Frame& F, const bf16* XB, const float* g, float* yp, float* ys) {
#pragma unroll 2
    for (int m = F.gw; m < MT; m += F.ngw) {
        const GAS v4u* xr = (const GAS v4u*)(XB + (size_t)m * DM) + F.lane;
        float v[4][8]; float s = 0.f;
#pragma unroll
        for (int j = 0; j < 4; ++j) { unpack8(xr[64 * j], v[j]);
#pragma unroll
            for (int e = 0; e < 8; ++e) s += v[j][e] * v[j][e]; }
        const float rstd = __builtin_amdgcn_rsqf(wave_sum(s) * (1.0f / DM) + RMS_EPS);
        float* dst = (m < MP) ? yp + (size_t)m * DM : ys + (size_t)(m - MP) * DM;
#pragma unroll
        for (int j = 0; j < 4; ++j) { float gg[8], o[8]; load8f(g + 512 * j + 8 * F.lane, gg);
#pragma unroll
            for (int e = 0; e < 8; ++e) o[e] = v[j][e] * rstd * gg[e];
            store8f(dst + 512 * j + 8 * F.lane, o); }
    }
}

__device__ __forceinline__ void p0_prologue(const Frame& F, CArgs* A, unsigned char* ws) {
    LAS float* scr = (LAS float*)(F.lds + RING_OFF + F.wave * 17408);
    bf16* WIN = (bf16*)(ws + WS_WIN); bf16* WOUT = (bf16*)(ws + WS_WOUT); bf16* GT = (bf16*)(ws + WS_GT); bf16* WQKV = (bf16*)(ws + WS_WQKV);
    bf16* WO = (bf16*)(ws + WS_WO); bf16* WUP = (bf16*)(ws + WS_WUP); bf16* WDN = (bf16*)(ws + WS_WDN);
    constexpr int IP_UP = (DM / 128) * (FF2 / 32), IP_DN = (FF / 128) * (DM / 32), IP_QKV = (DM / 128) * (NQKV / 32), IP_IN = (DM / 128) * (4096 / 32), IP_OUT = (DM / 128) * (DM / 32), IP_WO = (AW / 128) * (DM / 32), IP_G = (256 / 128) * (256 / 32);
    constexpr int NITEMS = 4 * IP_UP + 4 * IP_DN + 2 * IP_QKV + 2 * IP_IN + 2 * IP_OUT + 2 * IP_WO + 32 * IP_G;
#define P0_SEG(COUNT, IPM, CALL) if (r < (COUNT) * (IPM)) { const int mi = r / (IPM), item = r % (IPM); (void)mi; CALL; continue; } r -= (COUNT) * (IPM);
#define P0_UP(mat) p0_transpose_item<1>(A->in[I_FWUP] + (size_t)(mat) * DM * FF2, DM, FF2, WUP + (size_t)(mat) * DM * FF2, scr, item, F.lane, A->in[I_NFFN] + (size_t)(mat) * DM)
#define P0_DN(mat) p0_transpose_item(A->in[I_FWDN] + (size_t)(mat) * DM * FF, FF, DM, WDN + (size_t)(mat) * DM * FF, scr, item, F.lane)
#define P0_QKV(mat) p0_transpose_item(A->in[I_AWQKV] + (size_t)(mat) * DM * NQKV, DM, NQKV, WQKV + (size_t)(mat) * DM * NQKV, scr, item, F.lane, A->in[I_NMIX] + (size_t)(2 * (mat) + 1) * DM)
#define P0_IN(mat) p0_transpose_item(A->in[I_LWIN] + (size_t)(mat) * DM * 4096, DM, 4096, WIN + (size_t)(mat) * DM * 4096, scr, item, F.lane, A->in[I_NMIX] + (size_t)(2 * (mat)) * DM)
#define P0_OUT(mat) p0_transpose_item(A->in[I_LWOUT] + (size_t)(mat) * DM * DM, DM, DM, WOUT + (size_t)(mat) * DM * DM, scr, item, F.lane)
#define P0_WO(mat) p0_transpose_item(A->in[I_AWO] + (size_t)(mat) * AW * DM, AW, DM, WO + (size_t)(mat) * AW * DM, scr, item, F.lane)
    for (int it = F.gw; it < NITEMS; it += F.ngw) {
        int r = it;
        P0_SEG(3, IP_DN, P0_DN(3 - mi)) P0_SEG(3, IP_UP, P0_UP(3 - mi))
        P0_SEG(1, IP_QKV, P0_QKV(1)) P0_SEG(1, IP_WO, P0_WO(1)) P0_SEG(1, IP_IN, P0_IN(1)) P0_SEG(1, IP_OUT, P0_OUT(1))
        P0_SEG(1, IP_QKV, P0_QKV(0)) P0_SEG(1, IP_WO, P0_WO(0))
        P0_SEG(1, IP_DN, P0_DN(0)) P0_SEG(1, IP_UP, P0_UP(0))
        if (r < 32 * IP_G) { const int gate = r / (16 * IP_G); const int rr = r % (16 * IP_G); const int mat = rr / IP_G;
          p0_transpose_item(A->in[gate ? I_LWI : I_LWA] + (size_t)mat * 65536, 256, 256, GT + (size_t)(mat >> 3) * (4096 * 256) + (size_t)gate * (2048 * 256) + (size_t)(mat & 7) * 65536, scr, rr % IP_G, F.lane); continue; } r -= 32 * IP_G;
        P0_SEG(1, IP_OUT, P0_OUT(0)) P0_SEG(1, IP_IN, P0_IN(0))
    }
    if (F.gt < 2 * 2048) { float* SP = (float*)(ws + WS_MISC); SP[F.gt] = log1pf(expf(-A->in[I_LLAM][F.gt])); }
    rows_to_bf16_ss(F, A->in[I_XP], A->in[I_XS], (bf16*)(ws + WS_XN), (float*)(ws + WS_SSP), (float*)(ws + WS_SSS));
}

template <int NB, int UNR = 8, class Fn>
__device__ __forceinline__ void thin_gemm(const Frame& F, const bf16* A, int lda, int amod, const bf16* Bt, int N, int K, const Fn& fn, const float* sss = nullptr) {
    LAS float* red = (LAS float*)(F.lds + RING_OFF);
    const int fr = F.lane & 15, fq = F.lane >> 4;
    const int kper = K >> 3, k0 = F.wave * kper;
    float rsd = 1.0f;
    if (sss) { const float* p = sss + (size_t)(F.tid >> 4) * 128 + (F.tid & 15) * 8; const f32x4 a = *(const f32x4*)p, b = *(const f32x4*)(p + 4);
        float t = ((a[0] + a[1]) + (a[2] + a[3])) + ((b[0] + b[1]) + (b[2] + b[3])); t += xshf<1>(t); t += xshf<2>(t); t += xshf<4>(t); t += xshf<8>(t); rsd = rstd_ss(t); }
    const int nitems = N / 16; constexpr int nb = NB;
    for (int it0 = F.bx; it0 < nitems; it0 += nb * F.G) {
        const int it1 = it0 + F.G, it2 = it0 + 2 * F.G; const bool v1 = nb > 1 && it1 < nitems, v2 = nb > 1 && it2 < nitems;
        const int n0 = it0 * 16, n1 = (v1 ? it1 : it0) * 16, n2 = (v2 ? it2 : it0) * 16;
        const int acol = amod ? ((n0 >> 8) % amod) * K : 0;
        const bf16* ap0 = A + (size_t)fr * lda + acol + k0 + 8 * fq;
        const bf16* ap1 = ap0 + (size_t)16 * lda;
        const bf16* bp0 = Bt + (size_t)(n0 + fr) * K + k0 + 8 * fq; const bf16* bp1 = Bt + (size_t)(n1 + fr) * K + k0 + 8 * fq; const bf16* bp2 = Bt + (size_t)(n2 + fr) * K + k0 + 8 * fq;
        f32x4 acc[NB][2];
#pragma unroll
        for (int j = 0; j < NB; ++j) { acc[j][0] = (f32x4){0.f, 0.f, 0.f, 0.f}; acc[j][1] = (f32x4){0.f, 0.f, 0.f, 0.f}; }
#pragma unroll UNR
        for (int s = 0; s < kper; s += 32) {
            const bf16x8 a0 = *(const bf16x8*)(ap0 + s), a1 = *(const bf16x8*)(ap1 + s), b0 = *(const bf16x8*)(bp0 + s);
            acc[0][0] = __builtin_amdgcn_mfma_f32_16x16x32_bf16(a0, b0, acc[0][0], 0, 0, 0); acc[0][1] = __builtin_amdgcn_mfma_f32_16x16x32_bf16(a1, b0, acc[0][1], 0, 0, 0);
            if constexpr (NB > 1) { const bf16x8 b1 = *(const bf16x8*)(bp1 + s), b2 = *(const bf16x8*)(bp2 + s);
                acc[1][0] = __builtin_amdgcn_mfma_f32_16x16x32_bf16(a0, b1, acc[1][0], 0, 0, 0); acc[1][1] = __builtin_amdgcn_mfma_f32_16x16x32_bf16(a1, b1, acc[1][1], 0, 0, 0);
                acc[2][0] = __builtin_amdgcn_mfma_f32_16x16x32_bf16(a0, b2, acc[2][0], 0, 0, 0); acc[2][1] = __builtin_amdgcn_mfma_f32_16x16x32_bf16(a1, b2, acc[2][1], 0, 0, 0); }
        }
#pragma unroll
        for (int j = 0; j < NB; ++j)
#pragma unroll
            for (int r = 0; r < 4; ++r) { red[j * 4096 + F.wave * 512 + (4 * fq + r) * 16 + fr] = acc[j][0][r]; red[j * 4096 + F.wave * 512 + (16 + 4 * fq + r) * 16 + fr] = acc[j][1][r]; }
        __syncthreads();
#pragma unroll
        for (int j = 0; j < NB; ++j) { if (j == 0 || (j == 1 && v1) || (j == 2 && v2)) { float v = 0.f;
#pragma unroll
            for (int w = 0; w < 8; ++w) v += red[j * 4096 + w * 512 + F.tid];
            fn(F.tid >> 4, (j == 0 ? n0 : (j == 1 ? n1 : n2)) + (F.tid & 15), v * rsd); } }
        __syncthreads();
    }
}
struct TWin { bf16* GG; bf16* U; const float* bias;
    __device__ __forceinline__ void operator()(int r, int c, float v) const { v += bias[c]; if (c < 2048) GG[(size_t)(MP + r) * 2048 + c] = f2bf1(gelu_tanh(v)); else U[(size_t)(MP + r) * 2048 + c - 2048] = f2bf1(v); } };
struct TGates { bf16* OMA; bf16* GI; const bf16* UC; const float* b_a; const float* b_i; const float* sp;
    __device__ __forceinline__ void operator()(int r, int c, float v) const {
        if (c < 2048) OMA[(size_t)(MP + r) * 2048 + c] = f2bf1(1.0f - __builtin_amdgcn_exp2f(sigmoid_f(v + b_a[c]) * sp[c] * (-8.0f * 1.4426950409f)));
        else { c -= 2048; GI[(size_t)(MP + r) * 2048 + c] = f2bf1(sigmoid_f(v + b_i[c]) * bf2f(UC[(size_t)(MP + r) * 2048 + c])); } } };
struct TResid { bf16* XB; const float* bias; float* SSS;
    __device__ __forceinline__ void operator()(int r, int c, float v) const { const bf16 ob = f2bf1(bf2f(XB[(size_t)r * 2048 + c]) + v + (bias ? bias[c] : 0.f)); XB[(size_t)r * 2048 + c] = ob; const float o = bf2f(ob);
        float ss = o * o; ss += xshf<1>(ss); ss += xshf<2>(ss); ss += xshf<4>(ss); ss += xshf<8>(ss);
        if ((c & 15) == 0) SSS[(size_t)r * 128 + (c >> 4)] = ss; } };
struct TQkv { bf16* QKV; float* kvs0; int j;
    __device__ __forceinline__ void operator()(int r, int c, float v) const {
        QKV[(size_t)r * NQKV + c] = f2bf1(v);
        const int g = c / 3072, rem = c - g * 3072, part = rem >> 10;
        if (part) kvs0[(size_t)g * (O_KVS1 - O_KVS0) + ((size_t)(j * 32 + r) * 2 + (part - 1)) * 1024 + (rem & 1023)] = v; } };
struct TUp { bf16* UPS;
    __device__ __forceinline__ void operator()(int r, int c, float v) const { const int tl = c >> 8, x = c & 255; const int nat = x < 128 ? 128 * tl + x : 6144 + 128 * tl + (x - 128); UPS[(size_t)r * FF2 + nat] = f2bf1(v); } };

__device__ __forceinline__ void lru_conv_own(const Frame& F, CArgs* A, int j, const bf16* U, bf16* UC) {
    const float* cw = A->in[I_LCW] + (size_t)j * 4 * 2048; const float* cb = A->in[I_LCB] + (size_t)j * 2048; const float* st = A->in[I_SLC] + (size_t)j * SB * 3 * 2048;
    for (int P = F.bx; P < 256; P += F.G) {
        const int pm = P >> 3, hd = P & 7, c = hd * 256 + (F.tid & 31) * 8, m0 = pm * 256 + (F.tid >> 5) * 16, t0 = m0 & 4095;
        float w[4][8], bias[8], x3[8], x2[8], x1[8];
#pragma unroll
        for (int k = 0; k < 4; ++k) load8f(cw + (size_t)k * 2048 + c, w[k]);
        load8f(cb + c, bias);
        if (t0 != 0) { unpack8(*(const v4u*)(U + (size_t)(m0 - 3) * 2048 + c), x3); unpack8(*(const v4u*)(U + (size_t)(m0 - 2) * 2048 + c), x2); unpack8(*(const v4u*)(U + (size_t)(m0 - 1) * 2048 + c), x1); }
        else {
#pragma unroll
            for (int e = 0; e < 8; ++e) { x3[e] = 0.f; x2[e] = 0.f; x1[e] = 0.f; } }
#pragma unroll
        for (int r = 0; r < 16; ++r) { float x0[8], o[8]; unpack8(*(const v4u*)(U + (size_t)(m0 + r) * 2048 + c), x0);
#pragma unroll
            for (int e = 0; e < 8; ++e) o[e] = bias[e] + w[0][e] * x3[e] + w[1][e] * x2[e] + w[2][e] * x1[e] + w[3][e] * x0[e];
            *(v4u*)(UC + (size_t)(m0 + r) * 2048 + c) = pack8(o);
            if (t0 + r >= TSEQ - 3) store8f(A->out + O_LCP + ((size_t)(j * 2 + (m0 >> 12)) * 3 + (t0 + r - (TSEQ - 3))) * 2048 + c, x0);
#pragma unroll
            for (int e = 0; e < 8; ++e) { x3[e] = x2[e]; x2[e] = x1[e]; x1[e] = x0[e]; } }
    }
    for (int it = F.bx; it < 256; it += F.G) {
        const int hd = (it >> 4) & 7;
#pragma unroll
        for (int q2 = 0; q2 < 2; ++q2) { const int q = F.tid + 512 * q2, row = q >> 5, c = hd * 256 + (q & 31) * 8, b = row >> 2, t = row & 3; const int m = MP + row;
            float acc[8], x0[8] = {0.f, 0.f, 0.f, 0.f, 0.f, 0.f, 0.f, 0.f}; load8f(cb + c, acc);
#pragma unroll
            for (int k = 0; k < 4; ++k) { const int d = 3 - k; float w[8], x[8]; load8f(cw + (size_t)k * 2048 + c, w);
                if (t >= d) unpack8(*(const v4u*)(U + (size_t)(m - d) * 2048 + c), x); else load8f(st + ((size_t)b * 3 + (t + 3 - d)) * 2048 + c, x);
#pragma unroll
                for (int e = 0; e < 8; ++e) acc[e] += w[e] * x[e];
                if (k == 3) {
#pragma unroll
                    for (int e = 0; e < 8; ++e) x0[e] = x[e]; } }
            *(v4u*)(UC + (size_t)m * 2048 + c) = pack8(acc);
            if (t >= 1) store8f(A->out + O_LCS + ((size_t)(j * SB + b) * 3 + (t - 1)) * 2048 + c, x0); }
    }
    VM_WAIT(); __syncthreads();
}
__device__ __forceinline__ float fsqrt(float x) { return __builtin_amdgcn_sqrtf(x); }
__device__ __forceinline__ void scan_pass1(const Frame& F, const bf16* OMA, const bf16* GI, float* CA, float* CB) {
    for (int it = F.bx; it < 256; it += F.G) {
        const int q = it & 1, ch = (it >> 1) & 63, b = it >> 7, col = q * 1024 + 2 * F.tid;
        const size_t base = ((size_t)b * TSEQ + ch * 64) * 2048 + col;
        float A0 = 1.f, B0 = 0.f, A1 = 1.f, B1 = 0.f;
#pragma nounroll
        for (int r0 = 0; r0 < 64; r0 += 16) {
            unsigned ow[16], gw[16];
#pragma unroll
            for (int k = 0; k < 16; ++k) { ow[k] = *(const unsigned*)(OMA + base + (size_t)(r0 + k) * 2048); gw[k] = *(const unsigned*)(GI + base + (size_t)(r0 + k) * 2048); }
            __builtin_amdgcn_sched_barrier(0);
#pragma unroll
            for (int k = 0; k < 16; ++k) { const float o0 = bf_lo(ow[k]), o1 = bf_hi(ow[k]), a0 = 1.f - o0, a1 = 1.f - o1;
                A0 *= a0; B0 = a0 * B0 + fsqrt(o0 * (1.f + a0)) * bf_lo(gw[k]); A1 *= a1; B1 = a1 * B1 + fsqrt(o1 * (1.f + a1)) * bf_hi(gw[k]); }
        }
        *(f32x2*)(CA + (size_t)(b * 64 + ch) * 2048 + col) = (f32x2){A0, A1}; *(f32x2*)(CB + (size_t)(b * 64 + ch) * 2048 + col) = (f32x2){B0, B1};
    }
}
__device__ __forceinline__ void scan_pass2(const Frame& F, const float* CA, const float* CB, float* HIN) {
    LAS float* T = (LAS float*)(F.lds + RING_OFF);
    const int lc = F.tid & 63, g = F.wave;
    for (int it = F.bx; it < NBATCH * 32; it += F.G) {
        const int b = it >> 5, col = (it & 31) * 64 + lc;
        float a[8], c[8];
#pragma unroll
        for (int k = 0; k < 8; ++k) { const size_t i = (size_t)(b * 64 + g * 8 + k) * 2048 + col; a[k] = CA[i]; c[k] = CB[i]; }
        float Ag = 1.f, Bg = 0.f;
#pragma unroll
        for (int k = 0; k < 8; ++k) { Ag = a[k] * Ag; Bg = a[k] * Bg + c[k]; }
        *(LAS f32x2*)(T + (g * 64 + lc) * 2) = (f32x2){Ag, Bg};
        __syncthreads();
        float h = 0.f;
        for (int gg = 0; gg < g; ++gg) { const f32x2 t = *(const LAS f32x2*)(T + (gg * 64 + lc) * 2); h = t.x * h + t.y; }
#pragma unroll
        for (int k = 0; k < 8; ++k) { const size_t i = (size_t)(b * 64 + g * 8 + k) * 2048 + col; HIN[i] = h; h = a[k] * h + c[k]; }
        __syncthreads();
    }
}
__device__ __forceinline__ void scan_pass3(const Frame& F, CArgs* A, int j, const bf16* OMA, const bf16* GI, const float* HIN, const bf16* GG, bf16* HG) {
    for (int it = F.bx; it < 256; it += F.G) {
        const int q = it & 1, ch = (it >> 1) & 63, b = it >> 7, col = q * 1024 + 2 * F.tid;
        const size_t base = ((size_t)b * TSEQ + ch * 64) * 2048 + col;
        const f32x2 hin = *(const f32x2*)(HIN + (size_t)(b * 64 + ch) * 2048 + col); float h0 = hin.x, h1 = hin.y;
#pragma nounroll
        for (int r0 = 0; r0 < 64; r0 += 16) {
            unsigned ow[16], gw[16], ggw[16];
#pragma unroll
            for (int k = 0; k < 16; ++k) { const size_t i = base + (size_t)(r0 + k) * 2048; ow[k] = *(const unsigned*)(OMA + i); gw[k] = *(const unsigned*)(GI + i); ggw[k] = *(const unsigned*)(GG + i); }
            __builtin_amdgcn_sched_barrier(0);
#pragma unroll
            for (int k = 0; k < 16; ++k) { const size_t i = base + (size_t)(r0 + k) * 2048; const float o0 = bf_lo(ow[k]), o1 = bf_hi(ow[k]), a0 = 1.f - o0, a1 = 1.f - o1;
                h0 = a0 * h0 + fsqrt(o0 * (1.f + a0)) * bf_lo(gw[k]); h1 = a1 * h1 + fsqrt(o1 * (1.f + a1)) * bf_hi(gw[k]);
                *(unsigned*)(HG + i) = cvt_pk_bf16(h0 * bf_lo(ggw[k]), h1 * bf_hi(ggw[k])); }
        }
        if (ch == 63) *(f32x2*)(A->out + O_LHP + (size_t)(j * 2 + b) * 2048 + col) = (f32x2){h0, h1};
    }
    for (int i = F.gt; i < SB * 2048; i += F.ngt) { const int b = i >> 11, col = i & 2047; float h = A->in[I_SLH][(size_t)(j * SB + b) * 2048 + col];
#pragma unroll
        for (int t = 0; t < ST; ++t) { const size_t k = (size_t)(MP + b * ST + t) * 2048 + col; const float o = bf2f(OMA[k]), a = 1.f - o; h = a * h + fsqrt(o * (1.f + a)) * bf2f(GI[k]); HG[k] = f2bf1(h * bf2f(GG[k])); }
        A->out[O_LHS + (size_t)(j * SB + b) * 2048 + col] = h; }
}
__device__ __forceinline__ void ffn_fix(const Frame& F, CArgs* A, int layer, const bf16* HB, const bf16* UPS, bf16* ACT) {
    const float* cw = A->in[I_FCW] + (size_t)layer * 3 * FF2; const float* cb = A->in[I_FCB] + (size_t)layer * FF2; const float* st = A->in[I_SFC] + (size_t)layer * SB * 2 * FF2;
    constexpr int NSLAB = MP / 64;
    for (int idx = F.gt; idx < (NSLAB + SB) * 768; idx += F.ngt) {
        const int rb = idx / 768, c = (idx - rb * 768) * 8; const bool is_s = rb >= NSLAB;
        float wg[3][8], wv[3][8], bg[8], bv[8];
#pragma unroll
        for (int k = 0; k < 3; ++k) { load8f(cw + (size_t)k * FF2 + c, wg[k]); load8f(cw + (size_t)k * FF2 + FF + c, wv[k]); }
        load8f(cb + c, bg); load8f(cb + FF + c, bv);
        float g2[8], g1[8], v2[8], v1[8];
#pragma unroll
        for (int e = 0; e < 8; ++e) { g2[e] = 0.f; g1[e] = 0.f; v2[e] = 0.f; v1[e] = 0.f; }
        if (!is_s) {
            const int s = rb; const bf16* hb = HB + (size_t)s * 4 * FF2 + c;
            if ((s & 63) != 0) { unpack8(*(const v4u*)(hb - 2 * FF2), g2); unpack8(*(const v4u*)(hb - 1 * FF2), g1); unpack8(*(const v4u*)(hb - 2 * FF2 + FF), v2); unpack8(*(const v4u*)(hb - 1 * FF2 + FF), v1); }
#pragma unroll
            for (int r = 0; r < 2; ++r) { float ug[8], uv[8], o[8]; unpack8(*(const v4u*)(hb + (size_t)r * FF2), ug); unpack8(*(const v4u*)(hb + (size_t)r * FF2 + FF), uv);
#pragma unroll
                for (int e = 0; e < 8; ++e) { const float gg = bg[e] + wg[0][e] * g2[e] + wg[1][e] * g1[e] + wg[2][e] * ug[e]; const float vv = bv[e] + wv[0][e] * v2[e] + wv[1][e] * v1[e] + wv[2][e] * uv[e]; o[e] = gelu_tanh(gg) * vv; }
                *(v4u*)(ACT + (size_t)(s * 64 + r) * FF + c) = pack8(o);
#pragma unroll
                for (int e = 0; e < 8; ++e) { g2[e] = g1[e]; g1[e] = ug[e]; v2[e] = v1[e]; v1[e] = uv[e]; } }
            if ((s & 63) == 63) {
#pragma unroll
                for (int r = 0; r < 2; ++r) { float ug[8], uv[8]; unpack8(*(const v4u*)(hb + (size_t)(2 + r) * FF2), ug); unpack8(*(const v4u*)(hb + (size_t)(2 + r) * FF2 + FF), uv);
                    float* dst = A->out + O_FCP + ((size_t)(layer * 2 + (s >> 6)) * 2 + r) * FF2 + c; store8f(dst, ug); store8f(dst + FF, uv); } }
        } else {
            const int sb = rb - NSLAB;
            load8f(st + ((size_t)sb * 2 + 0) * FF2 + c, g2); load8f(st + ((size_t)sb * 2 + 1) * FF2 + c, g1); load8f(st + ((size_t)sb * 2 + 0) * FF2 + FF + c, v2); load8f(st + ((size_t)sb * 2 + 1) * FF2 + FF + c, v1);
#pragma unroll
            for (int r = 0; r < ST; ++r) { float ug[8], uv[8], o[8]; const bf16* up = UPS + (size_t)(sb * ST + r) * FF2 + c; unpack8(*(const v4u*)up, ug); unpack8(*(const v4u*)(up + FF), uv);
#pragma unroll
                for (int e = 0; e < 8; ++e) { const float gg = bg[e] + wg[0][e] * g2[e] + wg[1][e] * g1[e] + wg[2][e] * ug[e]; const float vv = bv[e] + wv[0][e] * v2[e] + wv[1][e] * v1[e] + wv[2][e] * uv[e]; o[e] = gelu_tanh(gg) * vv; }
                *(v4u*)(ACT + (size_t)(MP + sb * ST + r) * FF + c) = pack8(o);
                if (r >= 2) { float* dst = A->out + O_FCS + ((size_t)(layer * SB + sb) * 2 + (r - 2)) * FF2 + c; store8f(dst, ug); store8f(dst + FF, uv); }
#pragma unroll
                for (int e = 0; e < 8; ++e) { g2[e] = g1[e]; g1[e] = ug[e]; v2[e] = v1[e]; v1[e] = uv[e]; } }
        }
    }
}
constexpr int ATT_K_OFF = 0, ATT_V_OFF = 65536, ATT_S_OFF = 131072;
__device__ __forceinline__ void attn_decode(int tile, int& b, int& g, int& h, int& dil, int& p, int& n) {
    const int idx32 = tile & 31, bgh = tile >> 5; h = bgh & 7; g = (bgh >> 3) % 3; b = bgh / 24;
    dil = g == 0 ? 1 : (g == 1 ? 4 : 16); const int nb = 32 / dil; p = idx32 / nb; n = idx32 - p * nb;
}
#define ATT_PREFETCH_BLK(kbase_, blk_) do { const bf16* ks_ = (kbase_) + (size_t)((blk_) * 128 + kq) * 128 + ch * 8; \
        _Pragma("unroll") for (int i = 0; i < 4; ++i) { kraw[i] = *(const v4u*)(ks_ + (size_t)i * 32 * 128); vraw[i] = *(const v4u*)(ks_ + (size_t)i * 32 * 128 + (size_t)8 * 2 * 4096 * 128); } } while (0)
#define ATT_PREFETCH_Q(qbase_, blk_) do { const bf16* qb_ = (qbase_) + (size_t)((blk_) * 128 + 16 * w + fr) * 128 + 8 * fq; \
        _Pragma("unroll") for (int ks = 0; ks < 4; ++ks) bq[ks] = *(const bf16x8*)(qb_ + 32 * ks); } while (0)
typedef short att_v4i16 __attribute__((ext_vector_type(4)));
__device__ __forceinline__ void attn_prompt(const Frame& F, const bf16* QKV, bf16* OG, float* LSE) {
    LAS unsigned char* Kl = F.lds + RING_OFF + ATT_K_OFF;
    LAS unsigned char* Vl = F.lds + RING_OFF + ATT_V_OFF;
    const int w = F.wave;
    v4u kraw[4], vraw[4]; bf16x8 bq[4];
    for (int run = F.bx; run < 512; run += F.G) {
        int g, b, h, p, n0, nt;
        if (run < 256) { const int a = run & 127; g = run >> 7; b = a >> 6; h = (a >> 3) & 7; if (g == 0) { p = 0; n0 = 4 * (a & 7); } else { p = (a >> 1) & 3; n0 = 4 * (a & 1); } nt = 4; }
        else { const int c = run - 256; g = 2; b = c >> 7; h = (c >> 4) & 7; p = c & 15; n0 = 0; nt = 2; }
        const int dil = 1 << (2 * g), Lp = TSEQ >> (2 * g);
        const float slope = exp2f(-8.0f * (float)(g * 8 + h + 1) / 24.0f);
        const bf16* kbase = QKV + ((size_t)((g * 3 + 1) * 8 + h) * 2 + b) * (4096 * 128) + (size_t)(p * Lp) * 128;
        const bf16* qbase = QKV + ((size_t)((g * 3 + 0) * 8 + h) * 2 + b) * (4096 * 128) + (size_t)(p * Lp) * 128;
        const size_t orow0 = (size_t)g * MT + (size_t)b * TSEQ;
        { int lane_ = F.lane; asm volatile("" : "+v"(lane_)); const int kq = w * 4 + (lane_ >> 4), ch = lane_ & 15;
          if (n0 > 0) ATT_PREFETCH_BLK(kbase, n0 - 1); else {
#pragma unroll
              for (int i = 0; i < 4; ++i) { kraw[i] = (v4u){0u, 0u, 0u, 0u}; vraw[i] = (v4u){0u, 0u, 0u, 0u}; } } }
        for (int s = -1; s < nt; ++s) {
            const int n = n0 + s;
            int lane_ = F.lane; asm volatile("" : "+v"(lane_));
            const int fr = lane_ & 15, fq = lane_ >> 4, kq = w * 4 + (lane_ >> 4), ch = lane_ & 15;
            const int half = (n & 1) * 128;
#pragma unroll
            for (int i = 0; i < 4; ++i) { const int key = half + 32 * i + kq;
                *(LAS v4u*)(Kl + key * 256 + ((ch ^ (key & 15)) << 4)) = kraw[i];
                *(LAS v4u*)(Vl + key * 256 + ((((ch >> 1) ^ (key & 7)) << 5) | ((ch & 1) << 4))) = vraw[i]; }
            __syncthreads();
            if (s + 1 < nt) { ATT_PREFETCH_BLK(kbase, n + 1); if (s < 0) ATT_PREFETCH_Q(qbase, n + 1); }
            if (s >= 0) {
                const int tq = (128 * n + 16 * w + fr) * dil + p;
                const int hp = 128 - half;
                f32x4 S[10];
#pragma unroll
                for (int kb = 0; kb < 9; ++kb) { const int j = 16 * w + 16 * kb + fr; const int rowk = (j < 128 ? hp : half - 128) + j;
                    const LAS unsigned char* kp = Kl + rowk * 256; f32x4 acc = {0.f, 0.f, 0.f, 0.f};
#pragma unroll
                    for (int ks = 0; ks < 4; ++ks) { const bf16x8 ak = *(const LAS bf16x8*)(kp + (((4 * ks + fq) ^ fr) << 4)); acc = __builtin_amdgcn_mfma_f32_16x16x32_bf16(ak, bq[ks], acc, 0, 0, 0); }
                    S[kb] = acc; }
                if (s + 1 < nt) ATT_PREFETCH_Q(qbase, n + 1);
                float mx = -3.0e38f;
                {
                    const int dj0 = 4 * fq - fr;
                    const float c1 = slope * (float)dil, t0 = c1 * (float)(dj0 - 128); const int jj0 = (n > 0) ? 1024 : 16 * w + 4 * fq;
#pragma unroll
                    for (int kb = 0; kb < 9; ++kb)
#pragma unroll
                        for (int r = 0; r < 4; ++r) { const int dj = dj0 + (16 * kb + r); const bool valid = (unsigned)dj <= 128u && jj0 + (16 * kb + r) >= 128;
                            const float sv = fmaf(c1, (float)(16 * kb + r), fmaf(S[kb][r], 0.08838834764831845f, t0)); S[kb][r] = valid ? sv : -1.0e30f; mx = fmaxf(mx, S[kb][r]); }
                }
                mx = fmaxf(mx, xshf<16>(mx)); mx = half_max(mx);
                float den = 0.f;
#pragma unroll
                for (int kb = 0; kb < 9; ++kb)
#pragma unroll
                    for (int r = 0; r < 4; ++r) { const float pp = __expf(S[kb][r] - mx); S[kb][r] = pp; den += pp; }
                S[9] = (f32x4){0.f, 0.f, 0.f, 0.f};
                den += xshf<16>(den); den = half_sum(den);
                f32x4 O[8];
#pragma unroll
                for (int db = 0; db < 8; ++db) O[db] = (f32x4){0.f, 0.f, 0.f, 0.f};
#pragma unroll
                for (int ps = 0; ps < 5; ++ps) { const int kbA = 2 * ps, kbB = 2 * ps + 1;
                    v4u pw; pw.x = cvt_pk_bf16(S[kbA][0], S[kbA][1]); pw.y = cvt_pk_bf16(S[kbA][2], S[kbA][3]); pw.z = cvt_pk_bf16(S[kbB][0], S[kbB][1]); pw.w = cvt_pk_bf16(S[kbB][2], S[kbB][3]);
                    const bf16x8 pb = __builtin_bit_cast(bf16x8, pw);
                    int jA = 16 * w + 16 * kbA + 4 * fq, jB = jA + 16; jA = jA > 252 ? 252 : jA; jB = jB > 252 ? 252 : jB;
                    const int keyA = (jA < 128 ? hp : half - 128) + jA + (fr >> 2), keyB = (jB < 128 ? hp : half - 128) + jB + (fr >> 2);
                    const LAS unsigned char* vA = Vl + keyA * 256 + ((fr & 3) << 3); const LAS unsigned char* vB = Vl + keyB * 256 + ((fr & 3) << 3);
#pragma unroll
                    for (int db = 0; db < 8; ++db) {
                        const att_v4i16 lo = __builtin_amdgcn_ds_read_tr16_b64_v4i16((LAS att_v4i16*)(vA + ((db ^ (keyA & 7)) << 5)));
                        const att_v4i16 hi = __builtin_amdgcn_ds_read_tr16_b64_v4i16((LAS att_v4i16*)(vB + ((db ^ (keyB & 7)) << 5)));
                        const bf16x8 av = __builtin_shufflevector(lo, hi, 0, 1, 2, 3, 4, 5, 6, 7);
                        O[db] = __builtin_amdgcn_mfma_f32_16x16x32_bf16(av, pb, O[db], 0, 0, 0); } }
                const float inv = 1.0f / den; const size_t row = orow0 + tq;
#pragma unroll
                for (int db = 0; db < 8; ++db) { const f32x4 o = O[db] * inv; v2u w2; w2.x = cvt_pk_bf16(o[0], o[1]); w2.y = cvt_pk_bf16(o[2], o[3]); *(v2u*)(OG + row * AW + h * 128 + 16 * db + 4 * fq) = w2; }
                if (fq == 0) LSE[row * 8 + h] = mx + __logf(den);
            }
            __syncthreads();
        }
    }
}
__device__ __forceinline__ void attn_sample(const Frame& F, CArgs* A, int j, const bf16* QKV, bf16* OG, float* LSE) {
    LAS float* sm = (LAS float*)(F.lds + RING_OFF + ATT_S_OFF) + F.wave * 512;
    LAS float* qs = sm; LAS float* ps = sm + 128; LAS float* os = sm + 192; LAS float* ms = sm + 320;
    const int lane = F.lane, hf = F.wave & 1;
    float kscale = 0.08838834764831845f; asm volatile("" : "+s"(kscale));
    constexpr int NIT = SB * ST * 24;
    for (int it0 = F.bx; it0 < NIT; it0 += 4 * F.G) {
        const int it = it0 + F.G * (F.wave >> 1); const bool valid = it < NIT;
        float mx = 0.f, den = 1.f, o0 = 0.f, o1 = 0.f; size_t obase = 0, lbase = 0;
        if (valid) {
            const int h = it & 7, g = (it >> 3) % 3, t = (it / 24) & 3, b = it / 96;
            const int dil = g == 0 ? 1 : (g == 1 ? 4 : 16), win = 128 * dil;
            const float slope = exp2f(-8.0f * (float)(g * 8 + h + 1) / 24.0f);
            const float* cache = A->in[I_C128 + g] + ((size_t)(j * SB + b) * win) * 2048 + h * 128;
            const float* newkv = A->out + O_KVS0 + (size_t)g * (O_KVS1 - O_KVS0) + ((size_t)(j * SB + b) * ST) * 2048 + h * 128;
            const size_t orow = (size_t)g * MT + MP + b * ST + t; obase = orow * AW + h * 128; lbase = orow * 8 + h;
            const unsigned qw = *(const unsigned*)(QKV + (size_t)(b * ST + t) * NQKV + g * 3072 + h * 128 + 2 * lane);
            const int s = 64 * hf + lane, idx = win + t - s * dil;
            const float* kr = idx < win ? cache + (size_t)idx * 2048 : newkv + (size_t)(idx - win) * 2048;
            f32x2 k128 = (f32x2){0.f, 0.f};
            if (hf) k128 = *(const f32x2*)(cache + (size_t)t * 2048 + 2 * lane);
            *(LAS f32x2*)(qs + 2 * lane) = (f32x2){bf_lo(qw), bf_hi(qw)};
            LDS_WAIT();
            float acc = 0.f;
            f32x4 kk[32];
#pragma unroll
            for (int c = 0; c < 32; ++c) kk[c] = *(const f32x4*)(kr + 4 * c);
#pragma unroll
            for (int c0 = 0; c0 < 32; c0 += 8) { LAS float* qc = qs; asm volatile("" : "+v"(qc) : "v"(acc));
#pragma unroll
                for (int c = c0; c < c0 + 8; ++c) { const f32x4 qq = *(const LAS f32x4*)(qc + 4 * c); acc += (kk[c].x * qq.x + kk[c].y * qq.y) + (kk[c].z * qq.z + kk[c].w * qq.w); } }
            const float sc = acc * kscale - slope * (float)(s * dil);
            float sc128 = -3.0e38f;
            if (hf) { const f32x2 q2 = *(const LAS f32x2*)(qs + 2 * lane); sc128 = wave_sum(k128.x * q2.x + k128.y * q2.y) * kscale - slope * (float)(128 * dil); }
            mx = fmaxf(wave_max(sc), sc128);
            const float p = __expf(sc - mx), p128 = hf ? __expf(sc128 - mx) : 0.f;
            den = wave_sum(p) + p128;
            ps[lane] = p;
            LDS_WAIT();
#pragma nounroll
            for (int e0 = 0; e0 < 64; e0 += 32) {
                f32x2 vv[32];
#pragma unroll
                for (int e = 0; e < 32; ++e) { const int ix = win + t - (64 * hf + e0 + e) * dil;
                    const float* vr = (ix < win ? cache + (size_t)ix * 2048 : newkv + (size_t)(ix - win) * 2048) + 1024; vv[e] = *(const f32x2*)(vr + 2 * lane); }
#pragma unroll
                for (int e = 0; e < 32; ++e) { const float pp = ps[e0 + e]; o0 += pp * vv[e].x; o1 += pp * vv[e].y; }
            }
            if (hf) { const f32x2 v128 = *(const f32x2*)(cache + (size_t)t * 2048 + 1024 + 2 * lane); o0 += p128 * v128.x; o1 += p128 * v128.y;
                *(LAS f32x2*)(os + 2 * lane) = (f32x2){o0, o1}; if (lane == 0) { ms[0] = mx; ms[1] = den; } }
        }
        __syncthreads();
        if (valid && hf == 0) {
            const float mx1 = ms[512], den1 = ms[513]; const f32x2 ob = *(const LAS f32x2*)(os + 512 + 2 * lane);
            const float M = fmaxf(mx, mx1), a0 = __expf(mx - M), a1 = __expf(mx1 - M);
            const float dn = den * a0 + den1 * a1, inv = 1.0f / dn;
            *(unsigned*)(OG + obase + 2 * lane) = cvt_pk_bf16((o0 * a0 + ob.x * a1) * inv, (o1 * a0 + ob.y * a1) * inv);
            if (lane == 0) LSE[lbase] = M + __logf(dn);
        }
        __syncthreads();
    }
}
__device__ __forceinline__ void kv_prompt_out(const Frame& F, CArgs* A, int j, const bf16* QKV) {
#pragma unroll 4
    for (int idx = F.gt; idx < 5376 * 256; idx += F.ngt) {
        const int c = (idx & 127) * 8, kv = (idx >> 7) & 1; int rr = idx >> 8; int g, keep; size_t obase;
        if (rr < 256) { g = 0; keep = 128; obase = O_KVP0; } else if (rr < 1280) { g = 1; keep = 512; rr -= 256; obase = O_KVP1; } else { g = 2; keep = 2048; rr -= 1280; obase = O_KVP2; }
        const int b = rr / keep, r = rr - b * keep;
        const int t = TSEQ - keep + r, dsh = 2 * g, pos = ((t & ((1 << dsh) - 1)) << (12 - dsh)) + (t >> dsh);
        float x[8]; unpack8(*(const v4u*)(QKV + ((size_t)((g * 3 + 1 + kv) * 8 + (c >> 7)) * 2 + b) * (4096 * 128) + (size_t)pos * 128 + (c & 127)), x);
        store8f(A->out + obase + (((size_t)(j * 2 + b) * keep + r) * 2 + kv) * 1024 + c, x);
    }
}
__device__ __forceinline__ void attn_combine(const Frame& F, const bf16* OG, const float* LSE, bf16* O) {
#pragma unroll 4
    for (int idx = F.gt; idx < MT * 128; idx += F.ngt) {
        const int m = idx >> 7, hc = idx & 127, h = hc >> 4;
        const float l0 = LSE[((size_t)0 * MT + m) * 8 + h], l1 = LSE[((size_t)1 * MT + m) * 8 + h], l2 = LSE[((size_t)2 * MT + m) * 8 + h];
        const float mx = fmaxf(fmaxf(l0, l1), l2); float w0 = __expf(l0 - mx), w1 = __expf(l1 - mx), w2 = __expf(l2 - mx); const float inv = 1.0f / (w0 + w1 + w2); w0 *= inv; w1 *= inv; w2 *= inv;
        float a[8], bb[8], cc[8], o[8];
        unpack8(*(const v4u*)(OG + ((size_t)0 * MT + m) * AW + hc * 8), a); unpack8(*(const v4u*)(OG + ((size_t)1 * MT + m) * AW + hc * 8), bb); unpack8(*(const v4u*)(OG + ((size_t)2 * MT + m) * AW + hc * 8), cc);
#pragma unroll
        for (int e = 0; e < 8; ++e) o[e] = w0 * a[e] + w1 * bb[e] + w2 * cc[e];
        *(v4u*)(O + (size_t)m * AW + hc * 8) = pack8(o);
    }
}

#define PH const Frame F = mk_frame((LAS unsigned char*)lds, wv0); CArgs* A = kargs(); unsigned char* const ws = A->ws; LAS unsigned char* const ring = F.lds + RING_OFF; (void)ring; (void)ws;
#define P_X ((float*)(ws + WS_X))
#define P_XS (P_X + (size_t)MP * DM)
#define P_XN ((bf16*)(ws + WS_XN))
#define P_S (ws + WS_S)
#define P_GG ((bf16*)(P_S + S_GG))
#define P_U ((bf16*)(P_S + S_U))
#define P_UC ((bf16*)(P_S + S_UC))
#define P_HG ((bf16*)(P_S + S_HG))
#define P_LA ((bf16*)(P_S + S_LA))
#define P_GI ((bf16*)(P_S + S_GI))
#define P_QKV ((bf16*)(P_S + S_QKV))
#define P_QS (P_QKV + (size_t)MP * NQKV)
#define P_OG ((bf16*)(P_S + S_OG))
#define P_LSE ((float*)(P_S + S_LSE))
#define P_OB ((bf16*)(P_S + S_O))
#define P_UPS ((bf16*)(P_S + S_UPS))
#define P_HB ((bf16*)(P_S + S_HB))
#define P_ACT ((bf16*)(P_S + S_ACT))
#define P_CA ((float*)(ws + WS_SC))
#define P_CB ((float*)(ws + WS_SC + 1 * MiB))
#define P_HIN ((float*)(ws + WS_SC + 2 * MiB))
#define P_SP ((float*)(ws + WS_MISC))
#define P_SSP(k) ((float*)(ws + WS_SSP) + (size_t)(k) * MP * 8)
#define P_SSS(k) ((float*)(ws + WS_SSS) + (size_t)(k) * 32 * 128)
#define P_T ((pg8::PG8_LAS_T)(F.lds + EPI_T_OFF))
__global__ void __launch_bounds__(NWAVES * 64, 2) fwd(Args args_unused) {
    extern __shared__ __attribute__((aligned(16))) unsigned char lds[];
    XcdBarrier bar;
    const int wv0 = __builtin_amdgcn_readfirstlane((int)(threadIdx.x >> 6));
    {
        PH;
        for (int u = F.tid; u < (LDS_BYTES - LDSCTL_OFF) / 4; u += NTHR) ((LAS unsigned*)(F.lds + LDSCTL_OFF))[u] = 0u;
        __syncthreads();
        bar = xcd_barrier_post((unsigned*)((gu32*)(ws + WS_CTL) + CW_BAR), (volatile LAS unsigned*)(F.lds + MISC_OFF) + 8, wv0);
        p0_prologue(F, A, ws);
    }
    xcd_barrier(bar);

#pragma nounroll
    for (int pair = 0; pair < DEPTH / 2; ++pair) {
        {   const int layer = 2 * pair; const int j = layer >> 1; (void)j;
            {   PH;
                const bf16* Wl = (bf16*)(ws + WS_WIN) + (size_t)j * 4096 * DM; const float* b_in = A->in[I_LBIN] + (size_t)j * 4096;
                TWin fn{P_GG, P_U, b_in}; thin_gemm<1>(F, P_XN + (size_t)MP * DM, DM, 0, Wl, 4096, DM, fn, P_SSS(2 * layer));
                pg8::Gemm g{P_XN, Wl, MP, 4096, DM, DM, 0}; pg8::StaticOrder So; So.init(MP, 4096, F.G, F.bx);
                pg8::EpiBf<1> E{P_GG, DM, b_in, P_U, P_SSP(2 * layer)};
                pg8::gemm_phase<pg8::EpiBf<1>, pg8::StaticOrder, PG8_ALIGN, PG8_SP2>(ring, g, So, E, F.wave);
            }
            xcd_barrier(bar);
            {   PH;
                lru_conv_own(F, A, j, P_U, P_UC);
                const bf16* Gl = (bf16*)(ws + WS_GT) + (size_t)j * 4096 * 256; const float* b_a = A->in[I_LBA] + (size_t)j * 2048; const float* b_i = A->in[I_LBI] + (size_t)j * 2048; const float* sp = P_SP + (size_t)j * 2048;
                TGates fn{P_LA, P_GI, P_UC, b_a, b_i, sp}; thin_gemm<1>(F, P_UC + (size_t)MP * DM, DM, 8, Gl, 4096, 256, fn);
                pg8::Gemm g{P_UC, Gl, MP, 4096, 256, DM, 8}; pg8::GatesOrder So; So.init(F.G, F.bx);
                pg8::EpiGates E{P_LA, P_GI, P_UC, b_a, b_i, sp};
                pg8::gemm_phase<pg8::EpiGates, pg8::GatesOrder, PG8_ALIGN, PG8_SP2>(ring, g, So, E, F.wave);
            }
            xcd_barrier(bar);
            {   PH; scan_pass1(F, P_LA, P_GI, P_CA, P_CB); }
            xcd_barrier(bar);
            {   PH; scan_pass2(F, P_CA, P_CB, P_HIN); }
            xcd_barrier(bar);
            {   PH; scan_pass3(F, A, j, P_LA, P_GI, P_HIN, P_GG, P_HG); }
            xcd_barrier(bar);
            {   PH;
                const bf16* Wo = (bf16*)(ws + WS_WOUT) + (size_t)j * DM * DM; const float* b_out = A->in[I_LBOUT] + (size_t)j * DM;
                TResid fn{P_XN + (size_t)MP * DM, b_out, P_SSS(2 * layer + 1)}; thin_gemm<1>(F, P_HG + (size_t)MP * DM, DM, 0, Wo, DM, DM, fn);
                pg8::Gemm g{P_HG, Wo, MP, DM, DM, DM, 0}; pg8::StaticOrder So; So.init(MP, DM, F.G, F.bx);
                pg8::EpiResid E{P_XN, DM, b_out, P_SSP(2 * layer + 1), P_T};
                pg8::gemm_phase<pg8::EpiResid, pg8::StaticOrder, PG8_ALIGN, PG8_SP2>(ring, g, So, E, F.wave);
            }
            xcd_barrier(bar);
        }
        {   const int layer = 2 * pair; const int j = layer >> 1; (void)j;
        {   PH;
            const bf16* Wl = (bf16*)(ws + WS_WUP) + (size_t)layer * FF2 * DM;
            TUp fn{P_UPS}; thin_gemm<3>(F, P_XN + (size_t)MP * DM, DM, 0, Wl, FF2, DM, fn, P_SSS(2 * layer + 1));
            pg8::Gemm g{P_XN, Wl, MP, FF2, DM, DM, 0}; pg8::StaticOrder So; So.init(MP, FF2, F.G, F.bx);
            pg8::EpiUpGlu E{P_ACT, P_HB, A->in[I_FCW] + (size_t)layer * 3 * FF2, A->in[I_FCB] + (size_t)layer * FF2, P_SSP(2 * layer + 1)};
            pg8::gemm_phase<pg8::EpiUpGlu, pg8::StaticOrder, PG8_ALIGN, PG8_SP2>(ring, g, So, E, F.wave);
        }
        xcd_barrier(bar);
        {   PH; ffn_fix(F, A, layer, P_HB, P_UPS, P_ACT); }
        xcd_barrier(bar);
        {   PH;
            const bf16* Wl = (bf16*)(ws + WS_WDN) + (size_t)layer * DM * FF;
            TResid fn{P_XN + (size_t)MP * DM, nullptr, P_SSS(2 * layer + 2)}; thin_gemm<1, 12>(F, P_ACT + (size_t)MP * FF, FF, 0, Wl, DM, FF, fn);
            pg8::Gemm g{P_ACT, Wl, MP, DM, FF, FF, 0}; pg8::StaticOrder So; So.init(MP, DM, F.G, F.bx);
            pg8::EpiResid E{P_XN, DM, nullptr, P_SSP(2 * layer + 2), P_T};
            pg8::gemm_phase<pg8::EpiResid, pg8::StaticOrder, PG8_ALIGN, PG8_SP2>(ring, g, So, E, F.wave);
        }
        xcd_barrier(bar);
        if (layer == DEPTH - 1) { PH; norm_rows_out(F, P_XN, A->in[I_NFIN], A->out + O_YP, A->out + O_YS); }
        }
        {   const int layer = 2 * pair + 1; const int j = layer >> 1; (void)j;
            {   PH;
                const bf16* Wl = (bf16*)(ws + WS_WQKV) + (size_t)j * NQKV * DM;
                {   constexpr int NU = (MP / 256) * (NQKV / 256); const int rounds = (NU + F.G - 1) / F.G; int c0 = NU - (rounds - 1) * F.G; if (c0 >= F.G) c0 = 0;
                    if (F.bx >= c0) { Frame F2 = F; F2.bx = F.bx - c0; F2.G = F.G - c0; TQkv fn{P_QS, A->out + O_KVS0, j}; thin_gemm<3>(F2, P_XN + (size_t)MP * DM, DM, 0, Wl, NQKV, DM, fn, P_SSS(2 * layer)); } }
                pg8::Gemm g{P_XN, Wl, MP, NQKV, DM, DM, 0}; pg8::StaticOrder So; So.init(MP, NQKV, F.G, F.bx);
                pg8::EpiQkv E{P_QKV, P_SSP(2 * layer)};
                pg8::gemm_phase<pg8::EpiQkv, pg8::StaticOrder, PG8_ALIGN, PG8_SP2>(ring, g, So, E, F.wave);
            }
            xcd_barrier(bar);
            {   PH; attn_sample(F, A, j, P_QS, P_OG, P_LSE); __syncthreads(); attn_prompt(F, P_QKV, P_OG, P_LSE); kv_prompt_out(F, A, j, P_QKV); }
            xcd_barrier(bar);
            {   PH; attn_combine(F, P_OG, P_LSE, P_OB); }
            xcd_barrier(bar);
            {   PH;
                const bf16* Wo = (bf16*)(ws + WS_WO) + (size_t)j * DM * AW;
                TResid fn{P_XN + (size_t)MP * DM, nullptr, P_SSS(2 * layer + 1)}; thin_gemm<1>(F, P_OB + (size_t)MP * AW, AW, 0, Wo, DM, AW, fn);
                pg8::Gemm g{P_OB, Wo, MP, DM, AW, AW, 0}; pg8::StaticOrder So; So.init(MP, DM, F.G, F.bx);
                pg8::EpiResid E{P_XN, DM, nullptr, P_SSP(2 * layer + 1), P_T};
                pg8::gemm_phase<pg8::EpiResid, pg8::StaticOrder, PG8_ALIGN, PG8_SP2>(ring, g, So, E, F.wave);
            }
            xcd_barrier(bar);
        }
        {   const int layer = 2 * pair + 1; const int j = layer >> 1; (void)j;
        {   PH;
            const bf16* Wl = (bf16*)(ws + WS_WUP) + (size_t)layer * FF2 * DM;
            TUp fn{P_UPS}; thin_gemm<3>(F, P_XN + (size_t)MP * DM, DM, 0, Wl, FF2, DM, fn, P_SSS(2 * layer + 1));
            pg8::Gemm g{P_XN, Wl, MP, FF2, DM, DM, 0}; pg8::StaticOrder So; So.init(MP, FF2, F.G, F.bx);
            pg8::EpiUpGlu E{P_ACT, P_HB, A->in[I_FCW] + (size_t)layer * 3 * FF2, A->in[I_FCB] + (size_t)layer * FF2, P_SSP(2 * layer + 1)};
            pg8::gemm_phase<pg8::EpiUpGlu, pg8::StaticOrder, PG8_ALIGN, PG8_SP2>(ring, g, So, E, F.wave);
        }
        xcd_barrier(bar);
        {   PH; ffn_fix(F, A, layer, P_HB, P_UPS, P_ACT); }
        xcd_barrier(bar);
        {   PH;
            const bf16* Wl = (bf16*)(ws + WS_WDN) + (size_t)layer * DM * FF;
            TResid fn{P_XN + (size_t)MP * DM, nullptr, P_SSS(2 * layer + 2)}; thin_gemm<1, 12>(F, P_ACT + (size_t)MP * FF, FF, 0, Wl, DM, FF, fn);
            pg8::Gemm g{P_ACT, Wl, MP, DM, FF, FF, 0}; pg8::StaticOrder So; So.init(MP, DM, F.G, F.bx);
            pg8::EpiResid E{P_XN, DM, nullptr, P_SSP(2 * layer + 2), P_T};
            pg8::gemm_phase<pg8::EpiResid, pg8::StaticOrder, PG8_ALIGN, PG8_SP2>(ring, g, So, E, F.wave);
        }
        xcd_barrier(bar);
        if (layer == DEPTH - 1) { PH; norm_rows_out(F, P_XN, A->in[I_NFIN], A->out + O_YP, A->out + O_YS); }
        }
    }
}

extern "C" void kernel_launch(void* const* d_in, const int* in_sizes, int n_in, void* d_out, int out_size, void* d_ws, size_t ws_size, hipStream_t stream) {
    static int grid = 0;
    if (grid == 0) {
        if (n_in != N_IN || (size_t)out_size != O_END || ws_size < WS_END) { fprintf(stderr, "kernel_launch: unexpected shapes: n_in %d out %d ws %zu (need %zu)\n", n_in, out_size, ws_size, (size_t)WS_END); grid = -1; return; }
        int dev = 0, cus = 0, per_cu = 0;
        if (hipGetDevice(&dev) != hipSuccess || hipDeviceGetAttribute(&cus, hipDeviceAttributeMultiprocessorCount, dev) != hipSuccess) { grid = -1; return; }
        if (hipFuncSetAttribute((const void*)fwd, hipFuncAttributeMaxDynamicSharedMemorySize, LDS_BYTES) != hipSuccess) { fprintf(stderr, "kernel_launch: hipFuncSetAttribute failed\n"); grid = -1; return; }
        if (hipOccupancyMaxActiveBlocksPerMultiprocessor(&per_cu, (const void*)fwd, NWAVES * 64, LDS_BYTES) != hipSuccess || per_cu < 1) { fprintf(stderr, "kernel_launch: occupancy query reports %d blocks per CU\n", per_cu); }
        (void)hipGetLastError();
        grid = cus;
    }
    if (grid < 0) return;
    if (hipMemsetAsync((char*)d_ws + WS_CTL, 0, CTL_ZERO_BYTES, stream) != hipSuccess) return;
    Args a{};
    for (int i = 0; i < N_IN; ++i) a.in[i] = (const float*)d_in[i];
    a.out = (float*)d_out; a.ws = (unsigned char*)d_ws;
    hipLaunchKernelGGL(fwd, dim3(grid), dim3(NWAVES * 64), LDS_BYTES, stream, a);
}
```

```cpp
#include <hip/hip_runtime.h>
#include <cstdio>
#include <cstdint>
#include <cmath>
namespace pg8 {
#define PG8_LAS __attribute__((address_space(3)))
typedef unsigned short bf16_t;
typedef PG8_LAS float* PG8_LAS_T;
typedef short bf16x8 __attribute__((ext_vector_type(8)));
typedef float f32x4 __attribute__((ext_vector_type(4)));
typedef unsigned u32x4 __attribute__((ext_vector_type(4)));
constexpr int BM = 256, BK = 64, HALF = 128, HTB = HALF * BK * 2  , STAGE_BYTES = 8 * HTB, NXCD = 8, WGM = 8;

__host__ __device__ __forceinline__ int lds_byte(int r, int c) { const int st = (r >> 4) * 2 + (c >> 5), rr = r & 15, cc = c & 31, ob = rr * 64 + cc * 2; return st * 1024 + (ob ^ (((ob >> 9) & 1) << 5)); }
__host__ __device__ __forceinline__ void stage_rc(int b, int& R, int& C) { const int st = b / 1024, sb = b % 1024, swz = sb ^ (((sb >> 9) & 1) << 5); R = (st >> 1) * 16 + swz / 64; C = (st & 1) * 32 + (swz % 64) / 2; }
__host__ __device__ __forceinline__ int perm32(int rho) { const int n = rho >> 4, i = rho & 15; return 8 * (i >> 2) + 4 * n + (i & 3); }

struct Unit { int pm, pn; };
struct Gemm { const bf16_t* A; const bf16_t* Bt; int M, N, K, lda, amod; };

struct GatesOrder {
    int G, c;
    __host__ __device__ void init(int G_, int c_) { G = G_; c = c_; }
    __host__ __device__ bool next(int i, Unit& u) const { const int P = (i >> 1) * G + c; if (P >= 256) return false; u.pm = P >> 3; u.pn = (P & 7) + 8 * (i & 1); return true; }
    __device__ __forceinline__ void a_ready(const Unit&) const {}
    __device__ __forceinline__ void done(const Unit&) const {}
};
struct StaticOrder {
    int nM, nN, nwg, G, c;
    __host__ __device__ void init(int M, int N, int G_, int c_) { nM = M / BM; nN = N / BM; nwg = nM * nN; G = G_; c = c_; }
    __host__ __device__ bool next(int i, Unit& u) const {
        const long L = (long)i * G + c; if (L >= nwg) return false;
        int wgid = (int)L; { const int q = nwg / NXCD, r = nwg % NXCD, xcd = wgid % NXCD, off = wgid / NXCD; wgid = (xcd < r ? xcd * (q + 1) : r * (q + 1) + (xcd - r) * q) + off; }
        const int nig = WGM * nN, gid = wgid / nig, fm = gid * WGM, gsz = (nM - fm) < WGM ? (nM - fm) : WGM;
        u.pm = fm + ((wgid % nig) % gsz); u.pn = (wgid % nig) / gsz; return true;
    }
    __device__ __forceinline__ void a_ready(const Unit&) const {}
    __device__ __forceinline__ void done(const Unit&) const {}
};


__device__ __forceinline__ unsigned cvt_pk_bf16(float lo, float hi) { unsigned r; asm volatile("v_cvt_pk_bf16_f32 %0, %1, %2" : "=v"(r) : "v"(lo), "v"(hi)); return r; }
__device__ __forceinline__ float gelu_tanh(float x) { const float t = x * (1.5957691216f + 0.0713548163f * x * x); return x * __builtin_amdgcn_rcpf(1.0f + __builtin_amdgcn_exp2f(-1.4426950409f * t)); }
__device__ __forceinline__ f32x4 gelu_tanh4(f32x4 x) { const f32x4 t = x * x; const f32x4 u = t * (-0.10294325f) + (-2.3022082f); const f32x4 z = x * u;
    f32x4 e; e[0] = __builtin_amdgcn_exp2f(z[0]); e[1] = __builtin_amdgcn_exp2f(z[1]); e[2] = __builtin_amdgcn_exp2f(z[2]); e[3] = __builtin_amdgcn_exp2f(z[3]);
    const f32x4 d = e + 1.0f; f32x4 r; r[0] = __builtin_amdgcn_rcpf(d[0]); r[1] = __builtin_amdgcn_rcpf(d[1]); r[2] = __builtin_amdgcn_rcpf(d[2]); r[3] = __builtin_amdgcn_rcpf(d[3]); return x * r; }
typedef float f32x2g __attribute__((ext_vector_type(2)));
__device__ __forceinline__ f32x2g gelu_tanh2(f32x2g x) { const f32x2g t = x * x; const f32x2g u = t * (-0.10294325f) + (-2.3022082f); const f32x2g z = x * u;
    f32x2g e; e[0] = __builtin_amdgcn_exp2f(z[0]); e[1] = __builtin_amdgcn_exp2f(z[1]); const f32x2g d = e + 1.0f; f32x2g r; r[0] = __builtin_amdgcn_rcpf(d[0]); r[1] = __builtin_amdgcn_rcpf(d[1]); return x * r; }
__device__ __forceinline__ float sigmoid_f(float x) { return __builtin_amdgcn_rcpf(1.0f + __builtin_amdgcn_exp2f(-1.4426950409f * x)); }
__device__ __forceinline__ float bf_lo(unsigned w) { return __uint_as_float(w << 16); }
__device__ __forceinline__ float bf_hi(unsigned w) { return __uint_as_float(w & 0xffff0000u); }
template <int O> __device__ __forceinline__ float xshf(float v) { return __int_as_float(__builtin_amdgcn_ds_swizzle(__float_as_int(v), (O << 10) | 0x1f)); }
__device__ __forceinline__ float half_sum(float v) { const auto rr = __builtin_amdgcn_permlane32_swap(__float_as_uint(v), __float_as_uint(v), false, false); return __uint_as_float(rr[0]) + __uint_as_float(rr[1]); }
__device__ __forceinline__ float half_max(float v) { const auto rr = __builtin_amdgcn_permlane32_swap(__float_as_uint(v), __float_as_uint(v), false, false); return fmaxf(__uint_as_float(rr[0]), __uint_as_float(rr[1])); }
__device__ __forceinline__ float rstd_ss(float ss) { return __builtin_amdgcn_rsqf(ss * (1.0f / 2048.0f) + 1e-6f); }
__device__ __forceinline__ float rstd_row8(const float* p) { const f32x4 a = *(const f32x4*)p, b = *(const f32x4*)(p + 4); return rstd_ss(((a[0] + a[1]) + (a[2] + a[3])) + ((b[0] + b[1]) + (b[2] + b[3]))); }

struct PreRow { f32x4 a; };
__device__ __forceinline__ void pre_row_load(PreRow& p, const float* SSP, int pm, int tid) { p.a = *(const f32x4*)(SSP + (size_t)(pm * BM + (tid & 255)) * 8 + 4 * (tid >> 8)); }
__device__ __forceinline__ void pre_row_publish(PG8_LAS float* L, const PreRow& p, int tid) {
    const int t = tid & 255, ai = t >> 7, wr = (t >> 6) & 1, m = (t >> 4) & 3, fr = t & 15;
    L[(tid >> 8) * 256 + (ai * 2 + wr) * 64 + 4 * fr + m] = (p.a[0] + p.a[1]) + (p.a[2] + p.a[3]); }
__device__ __forceinline__ f32x4 pre_row_read(const PG8_LAS float* L, int ai, int wr, int fr) {
    const f32x4 s0 = *(const PG8_LAS f32x4*)(L + (ai * 2 + wr) * 64 + 4 * fr), s1 = *(const PG8_LAS f32x4*)(L + 256 + (ai * 2 + wr) * 64 + 4 * fr);
    return (f32x4){rstd_ss(s0[0] + s1[0]), rstd_ss(s0[1] + s1[1]), rstd_ss(s0[2] + s1[2]), rstd_ss(s0[3] + s1[3])}; }
template <int MODE> struct EpiBf {
    static constexpr bool HAS_PRE = true;
    static constexpr bool PERM = true, PERMA = false, AFTER_DRAIN = false;
    struct Pre { PreRow r; float c; };
    __device__ __forceinline__ Pre prefetch(const Unit& u, int tid) const { Pre p; pre_row_load(p.r, SSP, u.pm, tid); p.c = (MODE == 1 && tid < 256) ? bias[u.pn * BM + tid] : 0.f; return p; }
    bf16_t* O; int ldc; const float* bias; bf16_t* O2; const float* SSP;
    __device__ __forceinline__ void operator()(const f32x4 (&acc)[2][2][4][2], const Unit& u, int wr, int wc, int fr, int fq, const Pre& pre, PG8_LAS unsigned char* lds, int tid) const {
        const int row0 = u.pm * BM + wr * 64 + fr; int colt = u.pn * BM; bf16_t* base = O; bool act = false;
        if (MODE == 1) { if (u.pn >= 8) { base = O2; colt -= 2048; } else act = true; }
        const int col0 = colt + wc * 32 + 8 * fq;
        PG8_LAS float* L = (PG8_LAS float*)(lds + 131072);
        pre_row_publish(L, pre.r, tid);
        if (MODE == 1 && tid < 256) L[512 + tid] = pre.c;
        asm volatile("s_waitcnt lgkmcnt(0)" ::: "memory"); __builtin_amdgcn_s_barrier(); asm volatile("" ::: "memory");
        f32x4 bv[2][2]; f32x4 rsv[2];
#pragma unroll
        for (int bj = 0; bj < 2; ++bj)
#pragma unroll
            for (int n = 0; n < 2; ++n) bv[bj][n] = (MODE == 1) ? *(const PG8_LAS f32x4*)(L + 512 + bj * HALF + wc * 32 + 8 * fq + 4 * n) : (f32x4){0.f, 0.f, 0.f, 0.f};
#pragma unroll
        for (int ai = 0; ai < 2; ++ai) rsv[ai] = pre_row_read(L, ai, wr, fr);
#pragma unroll
        for (int ai = 0; ai < 2; ++ai)
#pragma unroll
            for (int m = 0; m < 4; ++m) { bf16_t* rowp = base + (size_t)(row0 + ai * HALF + m * 16) * ldc + col0; const float rs = rsv[ai][m];
#pragma unroll
                for (int bj = 0; bj < 2; ++bj) { f32x4 v0 = acc[ai][bj][m][0] * rs + bv[bj][0], v1 = acc[ai][bj][m][1] * rs + bv[bj][1];
                    if (MODE == 1) { if (act) {
#pragma unroll
                        for (int e = 0; e < 1; ++e) { v0 = gelu_tanh4(v0); v1 = gelu_tanh4(v1); } } }
                    u32x4 w; w.x = cvt_pk_bf16(v0[0], v0[1]); w.y = cvt_pk_bf16(v0[2], v0[3]); w.z = cvt_pk_bf16(v1[0], v1[1]); w.w = cvt_pk_bf16(v1[2], v1[3]);
                    *(u32x4*)(rowp + bj * HALF) = w; } }
    }
};
struct EpiQkv {
    static constexpr bool HAS_PRE = true;
    static constexpr bool PERM = true, PERMA = false, AFTER_DRAIN = false;
    bf16_t* QP; const float* SSP;
    typedef PreRow Pre;
    __device__ __forceinline__ Pre prefetch(const Unit& u, int tid) const { Pre p; pre_row_load(p, SSP, u.pm, tid); return p; }
    __device__ __forceinline__ void operator()(const f32x4 (&acc)[2][2][4][2], const Unit& u, int wr, int wc, int fr, int fq, const Pre& pre, PG8_LAS unsigned char* lds, int tid) const {
        PG8_LAS float* L = (PG8_LAS float*)(lds + 131072);
        pre_row_publish(L, pre, tid);
        asm volatile("s_waitcnt lgkmcnt(0)" ::: "memory"); __builtin_amdgcn_s_barrier(); asm volatile("" ::: "memory");
        f32x4 rsv[2];
#pragma unroll
        for (int ai = 0; ai < 2; ++ai) rsv[ai] = pre_row_read(L, ai, wr, fr);
        const int g = u.pn / 12, part = (u.pn - g * 12) >> 2, h0 = (u.pn & 3) * 2;
        const int dsh = 2 * g, lsh = 12 - dsh;
        const int row0 = u.pm * BM + wr * 64 + fr, b = row0 >> 12;
        bf16_t* base = QP + ((size_t)((g * 3 + part) * 8 + h0) * 2 + b) * (4096 * 128) + wc * 32 + 8 * fq;
#pragma unroll
        for (int ai = 0; ai < 2; ++ai)
#pragma unroll
            for (int m = 0; m < 4; ++m) { const int row = row0 + ai * HALF + m * 16, t = row & 4095; const int pos = ((t & ((1 << dsh) - 1)) << lsh) + (t >> dsh);
                const float rs = rsv[ai][m];
#pragma unroll
                for (int bj = 0; bj < 2; ++bj) { const f32x4 v0 = acc[ai][bj][m][0] * rs, v1 = acc[ai][bj][m][1] * rs;
                    u32x4 w; w.x = cvt_pk_bf16(v0[0], v0[1]); w.y = cvt_pk_bf16(v0[2], v0[3]); w.z = cvt_pk_bf16(v1[0], v1[1]); w.w = cvt_pk_bf16(v1[2], v1[3]);
                    *(u32x4*)(base + (size_t)bj * (2 * 4096 * 128) + (size_t)pos * 128) = w; } }
    }
};
struct EpiGates {
    static constexpr bool HAS_PRE = false;
    static constexpr bool PERM = true, PERMA = false, AFTER_DRAIN = false;
    bf16_t* OMA; bf16_t* GI; const bf16_t* UC; const float* b_a; const float* b_i; const float* sp;
    __device__ __forceinline__ void operator()(const f32x4 (&acc)[2][2][4][2], const Unit& u, int wr, int wc, int fr, int fq) const {
        const int row0 = u.pm * BM + wr * 64 + fr; const bool isA = u.pn < 8; const int col0 = (u.pn & 7) * BM + wc * 32 + 8 * fq;
        const float* bsrc = isA ? b_a : b_i;
        f32x4 bv[2][2], sv[2][2];
#pragma unroll
        for (int bj = 0; bj < 2; ++bj)
#pragma unroll
            for (int n = 0; n < 2; ++n) { bv[bj][n] = *(const f32x4*)(bsrc + col0 + bj * HALF + 4 * n); sv[bj][n] = *(const f32x4*)(sp + col0 + bj * HALF + 4 * n) * (-8.0f * 1.4426950409f); }
#pragma unroll
        for (int ai = 0; ai < 2; ++ai)
#pragma unroll
            for (int m = 0; m < 4; ++m) { const size_t off = (size_t)(row0 + ai * HALF + m * 16) * 2048 + col0;
#pragma unroll
                for (int bj = 0; bj < 2; ++bj) { const f32x4 v0 = acc[ai][bj][m][0] + bv[bj][0], v1 = acc[ai][bj][m][1] + bv[bj][1]; float o[8];
                    if (isA) {
#pragma unroll
                        for (int e = 0; e < 4; ++e) { o[e] = 1.0f - __builtin_amdgcn_exp2f(sigmoid_f(v0[e]) * sv[bj][0][e]); o[4 + e] = 1.0f - __builtin_amdgcn_exp2f(sigmoid_f(v1[e]) * sv[bj][1][e]); }
                    } else {
                        const u32x4 uw = *(const u32x4*)(UC + off + bj * HALF);
                        o[0] = sigmoid_f(v0[0]) * bf_lo(uw.x); o[1] = sigmoid_f(v0[1]) * bf_hi(uw.x); o[2] = sigmoid_f(v0[2]) * bf_lo(uw.y); o[3] = sigmoid_f(v0[3]) * bf_hi(uw.y);
                        o[4] = sigmoid_f(v1[0]) * bf_lo(uw.z); o[5] = sigmoid_f(v1[1]) * bf_hi(uw.z); o[6] = sigmoid_f(v1[2]) * bf_lo(uw.w); o[7] = sigmoid_f(v1[3]) * bf_hi(uw.w);
                    }
                    u32x4 w; w.x = cvt_pk_bf16(o[0], o[1]); w.y = cvt_pk_bf16(o[2], o[3]); w.z = cvt_pk_bf16(o[4], o[5]); w.w = cvt_pk_bf16(o[6], o[7]);
                    if (isA) *(u32x4*)(OMA + off + bj * HALF) = w; else *(u32x4*)(GI + off + bj * HALF) = w; } }
    }
};
struct EpiResid {
    static constexpr bool HAS_PRE = true;
    struct Pre { float c; };
    __device__ __forceinline__ Pre prefetch(const Unit& u, int tid) const { Pre p; p.c = (bias && tid < 256) ? bias[u.pn * BM + tid] : 0.f; return p; }
    static constexpr bool PERM = true, PERMA = false, AFTER_DRAIN = false;
    bf16_t* XB; int ldc; const float* bias; float* SSP; PG8_LAS float* T;
    __device__ __forceinline__ void operator()(const f32x4 (&acc)[2][2][4][2], const Unit& u, int wr, int wc, int fr, int fq, const Pre& pre, PG8_LAS unsigned char* lds, int tid) const {
        const int row0 = u.pm * BM + wr * 64 + fr, col0 = u.pn * BM + wc * 32 + 8 * fq;
        PG8_LAS float* LB = (PG8_LAS float*)(lds + 131072 + 4096);
        if (tid < 256) LB[tid] = pre.c;
        asm volatile("s_waitcnt lgkmcnt(0)" ::: "memory"); __builtin_amdgcn_s_barrier(); asm volatile("" ::: "memory");
        const PG8_LAS float* lb = LB + wc * 32 + 8 * fq;
        u32x4 xin[2][4][2];
#pragma unroll
        for (int ai = 0; ai < 2; ++ai)
#pragma unroll
            for (int m = 0; m < 4; ++m)
#pragma unroll
                for (int bj = 0; bj < 2; ++bj) xin[ai][m][bj] = *(const u32x4*)(XB + (size_t)(row0 + ai * HALF + m * 16) * ldc + col0 + bj * HALF);
        __builtin_amdgcn_sched_barrier(0);
#pragma unroll
        for (int ai = 0; ai < 2; ++ai)
#pragma unroll
            for (int m = 0; m < 4; ++m) { const int row = row0 + ai * HALF + m * 16; const size_t off = (size_t)row * ldc + col0; float ss = 0.f;
#pragma unroll
                for (int bj = 0; bj < 2; ++bj) { const u32x4 xw = xin[ai][m][bj];
                    const f32x4 b0 = *(const PG8_LAS f32x4*)(lb + bj * HALF), b1 = *(const PG8_LAS f32x4*)(lb + bj * HALF + 4);
                    const f32x4 v0 = (f32x4){bf_lo(xw.x), bf_hi(xw.x), bf_lo(xw.y), bf_hi(xw.y)} + acc[ai][bj][m][0] + b0, v1 = (f32x4){bf_lo(xw.z), bf_hi(xw.z), bf_lo(xw.w), bf_hi(xw.w)} + acc[ai][bj][m][1] + b1;
                    u32x4 w; w.x = cvt_pk_bf16(v0[0], v0[1]); w.y = cvt_pk_bf16(v0[2], v0[3]); w.z = cvt_pk_bf16(v1[0], v1[1]); w.w = cvt_pk_bf16(v1[2], v1[3]);
                    *(u32x4*)(XB + off + bj * HALF) = w;
                    const float r0 = bf_lo(w.x), r1 = bf_hi(w.x), r2 = bf_lo(w.y), r3 = bf_hi(w.y), r4 = bf_lo(w.z), r5 = bf_hi(w.z), r6 = bf_lo(w.w), r7 = bf_hi(w.w);
                    ss += ((r0 * r0 + r1 * r1) + (r2 * r2 + r3 * r3)) + ((r4 * r4 + r5 * r5) + (r6 * r6 + r7 * r7)); }
                ss += xshf<16>(ss); ss = half_sum(ss);
                if (fq == 0) T[(ai * HALF + wr * 64 + m * 16 + fr) * 4 + wc] = ss; }
        asm volatile("s_waitcnt lgkmcnt(0)" ::: "memory"); __builtin_amdgcn_s_barrier(); asm volatile("" ::: "memory");
        if (tid < 256) { const f32x4 t = *(const PG8_LAS f32x4*)(T + tid * 4); SSP[(size_t)(u.pm * BM + tid) * 8 + u.pn] = (t[0] + t[1]) + (t[2] + t[3]); }
    }
};

__device__ __forceinline__ float dpp_shr1(float v) { return __builtin_bit_cast(float, __builtin_amdgcn_update_dpp(0, __builtin_bit_cast(int, v), 0x111, 0xf, 0xf, true)); }
struct EpiUpGlu {
    static constexpr bool PERM = true, PERMA = true, AFTER_DRAIN = false, HAS_PRE = true;
    bf16_t* ACT; bf16_t* HB; const float* cw; const float* cb; const float* SSP;
    struct Pre { f32x4 a, b; };
    __device__ __forceinline__ Pre prefetch(const Unit& u, int tid) const {
        Pre p;
        if (tid < 256) { const float* sp = SSP + (size_t)(u.pm * BM + tid) * 8; p.a = *(const f32x4*)sp; p.b = *(const f32x4*)(sp + 4); }
        else { const int i = tid - 256, arr = i >> 5, c4 = (i & 31) * 4; const int k = arr < 3 ? arr : arr - 3;
            const size_t off = (arr < 6 ? (size_t)k * 12288 : (size_t)0) + ((arr >= 3 && arr != 6) ? 6144 : 0) + (size_t)u.pn * 128 + c4;
            const float* base = arr < 6 ? cw : cb; p.a = *(const f32x4*)(base + off); p.b = p.a; }
        return p;
    }
    __device__ __forceinline__ void operator()(const f32x4 (&acc)[2][2][4][2], const Unit& u, int wr, int wc, int fr, int fq, const Pre& pre, PG8_LAS unsigned char* lds, int tid) const {
        const int gcol = u.pn * 128 + wc * 32 + 8 * fq;
        PG8_LAS float* L = (PG8_LAS float*)(lds + 131072);
        if (tid < 256) L[tid] = rstd_ss(((pre.a[0] + pre.a[1]) + (pre.a[2] + pre.a[3])) + ((pre.b[0] + pre.b[1]) + (pre.b[2] + pre.b[3])));
        else *(PG8_LAS f32x4*)(L + 256 + (tid - 256) * 4) = pre.a;
        asm volatile("s_waitcnt lgkmcnt(0)" ::: "memory"); __builtin_amdgcn_s_barrier(); asm volatile("" ::: "memory");
        float rs[2][4];
#pragma unroll
        for (int ai = 0; ai < 2; ++ai) { const f32x4 r = *(const PG8_LAS f32x4*)(L + (ai * 2 + wr) * 64 + 4 * fr);
#pragma unroll
            for (int m = 0; m < 4; ++m) rs[ai][m] = r[m]; }
        const PG8_LAS float* LW = L + 256 + wc * 32 + 8 * fq;
        if (fr == 0 || fr == 15) { const bool hi = fr == 15;
            typedef unsigned u32x2h __attribute__((ext_vector_type(2)));
#pragma unroll
            for (int ai = 0; ai < 2; ++ai) { const int slab = u.pm * 4 + ai * 2 + wr;
#pragma unroll
                for (int r = 0; r < 2; ++r) { const float rsel = hi ? rs[ai][2 + r] : rs[ai][r]; bf16_t* hp = HB + ((size_t)slab * 4 + (hi ? 2 + r : r)) * 12288 + gcol;
#pragma unroll
                    for (int n = 0; n < 2; ++n) { const f32x4 ga = acc[ai][0][r][n], gb = acc[ai][0][2 + r][n], va = acc[ai][1][r][n], vb = acc[ai][1][2 + r][n];
                        f32x4 gsel, vsel;
#pragma unroll
                        for (int q = 0; q < 4; ++q) { gsel[q] = (hi ? gb[q] : ga[q]) * rsel; vsel[q] = (hi ? vb[q] : va[q]) * rsel; }
                        u32x2h hg, hv; hg.x = cvt_pk_bf16(gsel[0], gsel[1]); hg.y = cvt_pk_bf16(gsel[2], gsel[3]); hv.x = cvt_pk_bf16(vsel[0], vsel[1]); hv.y = cvt_pk_bf16(vsel[2], vsel[3]);
                        *(u32x2h*)(hp + 4 * n) = hg; *(u32x2h*)(hp + 6144 + 4 * n) = hv; } } } }
        typedef unsigned u32x2 __attribute__((ext_vector_type(2)));
        u32x2 pk[2][4];
#pragma unroll
        for (int n = 0; n < 2; ++n) {
            f32x4 wg[3], wv[3];
#pragma unroll
            for (int k = 0; k < 3; ++k) { wg[k] = *(const PG8_LAS f32x4*)(LW + k * 128 + 4 * n); wv[k] = *(const PG8_LAS f32x4*)(LW + (3 + k) * 128 + 4 * n); }
            const f32x4 bg = *(const PG8_LAS f32x4*)(LW + 6 * 128 + 4 * n), bv = *(const PG8_LAS f32x4*)(LW + 7 * 128 + 4 * n);
#pragma unroll
            for (int ai = 0; ai < 2; ++ai) {
                const int slab = u.pm * 4 + ai * 2 + wr; const int row0 = slab * 64 + 4 * fr;
                f32x4 g1, g2, v1, v2;
                const f32x4 sg2 = acc[ai][0][2][n] * rs[ai][2], sg3 = acc[ai][0][3][n] * rs[ai][3], sv2 = acc[ai][1][2][n] * rs[ai][2], sv3 = acc[ai][1][3][n] * rs[ai][3];
#pragma unroll
                for (int e = 0; e < 4; ++e) { g1[e] = dpp_shr1(sg3[e]); g2[e] = dpp_shr1(sg2[e]); v1[e] = dpp_shr1(sv3[e]); v2[e] = dpp_shr1(sv2[e]); }
#pragma unroll
                for (int m = 0; m < 4; ++m) { const f32x4 gc = m == 2 ? sg2 : (m == 3 ? sg3 : acc[ai][0][m][n] * rs[ai][m]), vc = m == 2 ? sv2 : (m == 3 ? sv3 : acc[ai][1][m][n] * rs[ai][m]);
                    const f32x4 cg = bg + wg[0] * g2 + wg[1] * g1 + wg[2] * gc, cv = bv + wv[0] * v2 + wv[1] * v1 + wv[2] * vc;
                    const f32x4 gl = gelu_tanh4(cg) * cv; u32x2 o; o.x = cvt_pk_bf16(gl[0], gl[1]); o.y = cvt_pk_bf16(gl[2], gl[3]);
                    if (n == 0) pk[ai][m] = o;
                    else if (!(fr == 0 && m < 2)) { u32x4 w; w.x = pk[ai][m].x; w.y = pk[ai][m].y; w.z = o.x; w.w = o.y; *(u32x4*)(ACT + (size_t)(row0 + m) * 6144 + gcol) = w; }
                    g2 = g1; g1 = gc; v2 = v1; v1 = vc; }
            }
        }
    }
};

struct EpiNull {
    static constexpr bool HAS_PRE = false;
    static constexpr bool PERM = true, PERMA = true, AFTER_DRAIN = false;
    float* sink;
    __device__ __forceinline__ void operator()(const f32x4 (&acc)[2][2][4][2], const Unit& u, int wr, int wc, int fr, int fq) const {
        float s = 0.f;
#pragma unroll
        for (int ai = 0; ai < 2; ++ai)
#pragma unroll
            for (int bj = 0; bj < 2; ++bj)
#pragma unroll
                for (int m = 0; m < 4; ++m)
#pragma unroll
                    for (int n = 0; n < 2; ++n) s += acc[ai][bj][m][n][0] + acc[ai][bj][m][n][1] + acc[ai][bj][m][n][2] + acc[ai][bj][m][n][3];
        if (s == 12345.678f) sink[u.pm] = s;
    }
};

struct NoPreT {};
template <class Epi, bool H> struct PreOf { typedef NoPreT type; };
template <class Epi> struct PreOf<Epi, true> { typedef typename Epi::Pre type; };
template <class Epi, class Sched, bool ALIGN_EPI = false, bool SP2 = false>
__device__ __forceinline__ void gemm_phase(PG8_LAS unsigned char* lds, const Gemm g, const Sched& S, const Epi& E, const int wv) {
    int lane; asm volatile("v_mbcnt_lo_u32_b32 %0, -1, 0\n\tv_mbcnt_hi_u32_b32 %0, -1, %0" : "=v"(lane)); const int wid = wv, tid = wv * 64 + lane, wr = wid >> 2, wc = wid & 3, fr = lane & 15, fq = lane >> 4;
    int K_ = g.K; asm volatile("" : "+s"(K_)); const int K = K_, nt = K / BK;
    unsigned voffA[2], voffB[2];
#pragma unroll
    for (int i = 0; i < 2; ++i) { int R, C; stage_rc(tid * 16 + i * 8192, R, C); const int Rb = Epi::PERM ? ((R & ~31) + perm32(R & 31)) : R;
        const int Ra = Epi::PERMA ? ((R & ~63) + 4 * (R & 15) + ((R >> 4) & 3)) : R;
        voffA[i] = (unsigned)(Ra * g.lda + C) * 2u; voffB[i] = (unsigned)(Rb * K + C) * 2u; }
    const size_t kstep = (size_t)(BK * 2);
    const size_t hstepB = (size_t)HALF * K * 2, hstepA = (size_t)HALF * g.lda * 2;
    const size_t tstepA = 2 * hstepA, tstepB = 2 * hstepB;
    const unsigned ldsw = (unsigned)wid * 1024u;
    const int aoff = lds_byte(wr * 64 + fr, fq * 8), boff = lds_byte(wc * 32 + fr, fq * 8);
#define PG8_SA(b, h) (((b) * 2 + (h)) * HTB)
#define PG8_SB(b, h) ((4 + (b) * 2 + (h)) * HTB)
#define PG8_STAGE(bufoff, gbase, voff) do { _Pragma("unroll") for (int _i = 0; _i < 2; ++_i) \
        __builtin_amdgcn_global_load_lds((const unsigned*)((const char*)(gbase) + (voff)[_i]), (PG8_LAS unsigned*)(lds + (bufoff) + ldsw + _i * 8192), 16, 0, 0); } while (0)
#define PG8_LDA(dst, b, h) do { _Pragma("unroll") for (int m = 0; m < 4; ++m) _Pragma("unroll") for (int k = 0; k < 2; ++k) dst[m][k] = *(const PG8_LAS bf16x8*)(lds + PG8_SA(b, h) + aoff + m * 2048 + k * 1024); } while (0)
#define PG8_LDB(dst, b, h) do { _Pragma("unroll") for (int n = 0; n < 2; ++n) _Pragma("unroll") for (int k = 0; k < 2; ++k) dst[n][k] = *(const PG8_LAS bf16x8*)(lds + PG8_SB(b, h) + boff + n * 2048 + k * 1024); } while (0)
#define PG8_MMA(ai, bj, At, Bt) do { __builtin_amdgcn_s_setprio(1); _Pragma("unroll") for (int m = 0; m < 4; ++m) _Pragma("unroll") for (int n = 0; n < 2; ++n) _Pragma("unroll") for (int k = 0; k < 2; ++k) \
        acc[ai][bj][m][n] = __builtin_amdgcn_mfma_f32_16x16x32_bf16(Bt[n][k], At[m][k], acc[ai][bj][m][n], 0, 0, 0); __builtin_amdgcn_s_setprio(0); } while (0)
#define PG8_WAIT_V(n) asm volatile("s_waitcnt vmcnt(" #n ")" ::: "memory")
#define PG8_WAIT_L(n) asm volatile("s_waitcnt lgkmcnt(" #n ")" ::: "memory")
#define PG8_BAR __builtin_amdgcn_s_barrier()
#define PG8_SCHED __builtin_amdgcn_sched_barrier(0)
    Unit cur, nxt; int ui = 0;
    if (!S.next(0, cur)) return;
    f32x4 acc[2][2][4][2];
#pragma unroll
    for (int a = 0; a < 2; ++a)
#pragma unroll
        for (int b = 0; b < 2; ++b)
#pragma unroll
            for (int m = 0; m < 4; ++m)
#pragma unroll
                for (int n = 0; n < 2; ++n) acc[a][b][m][n] = (f32x4){0.f, 0.f, 0.f, 0.f};
    bf16x8 At[4][2], B0[2][2], B1[2][2];
    const char* cA = (const char*)g.A + (size_t)cur.pm * tstepA + (g.amod ? (size_t)(cur.pn % g.amod) * K * 2 : (size_t)0); const char* cB = (const char*)g.Bt + (size_t)cur.pn * tstepB;
    S.a_ready(cur);
    typename PreOf<Epi, Epi::HAS_PRE>::type pre; if constexpr (Epi::HAS_PRE) pre = E.prefetch(cur, tid);
    if constexpr (SP2) {
        PG8_STAGE(PG8_SB(0, 0), cB, voffB); PG8_STAGE(PG8_SB(0, 1), cB + hstepB, voffB); PG8_STAGE(PG8_SA(0, 0), cA, voffA); PG8_STAGE(PG8_SA(0, 1), cA + hstepA, voffA);
        if (wr == 1) PG8_BAR;
        PG8_WAIT_V(2); PG8_BAR;
        PG8_STAGE(PG8_SB(1, 0), cB + kstep, voffB); PG8_STAGE(PG8_SA(1, 0), cA + kstep, voffA); PG8_STAGE(PG8_SB(1, 1), cB + hstepB + kstep, voffB);
        PG8_WAIT_V(6); PG8_BAR;
    } else {
        PG8_STAGE(PG8_SB(0, 0), cB, voffB); PG8_STAGE(PG8_SA(0, 0), cA, voffA); PG8_STAGE(PG8_SB(0, 1), cB + hstepB, voffB); PG8_STAGE(PG8_SA(0, 1), cA + hstepA, voffA);
        if (wr == 1) PG8_BAR;
        PG8_WAIT_V(4); PG8_BAR;
        PG8_STAGE(PG8_SB(1, 0), cB + kstep, voffB); PG8_STAGE(PG8_SA(1, 0), cA + kstep, voffA); PG8_STAGE(PG8_SB(1, 1), cB + hstepB + kstep, voffB);
        PG8_WAIT_V(6); PG8_BAR;
    }
    for (;;) {
        const bool has_next = S.next(ui + 1, nxt);
        const char* nA = has_next ? (const char*)g.A + (size_t)nxt.pm * tstepA + (g.amod ? (size_t)(nxt.pn % g.amod) * K * 2 : (size_t)0) : cA; const char* nB = has_next ? (const char*)g.Bt + (size_t)nxt.pn * tstepB : cB;
        for (int t = 0; t < nt; t += 2) {
            const bool last = (t == nt - 2);
            const char* a1 = cA + (size_t)(t + 1) * kstep;
            const char* a2 = last ? nA : cA + (size_t)(t + 2) * kstep; const char* b2 = last ? nB : cB + (size_t)(t + 2) * kstep;
            const char* a3 = a2 + kstep; const char* b3 = b2 + kstep;
            if (last && has_next) S.a_ready(nxt);
            if constexpr (SP2) {
            PG8_LDB(B0, 0, 0); PG8_LDB(B1, 0, 1); PG8_SCHED; PG8_LDA(At, 0, 0); PG8_STAGE(PG8_SA(1, 1), a1 + hstepA, voffA);
            PG8_WAIT_V(8); PG8_WAIT_L(0); PG8_BAR; PG8_MMA(0, 0, At, B0); PG8_MMA(0, 1, At, B1); PG8_BAR; PG8_SCHED;
            PG8_LDA(At, 0, 1); PG8_STAGE(PG8_SB(0, 0), b2, voffB); PG8_STAGE(PG8_SB(0, 1), b2 + hstepB, voffB); PG8_STAGE(PG8_SA(0, 0), a2, voffA);
            PG8_WAIT_V(8); PG8_WAIT_L(0); PG8_BAR; PG8_MMA(1, 0, At, B0); PG8_MMA(1, 1, At, B1); PG8_BAR; PG8_SCHED;
            PG8_LDB(B0, 1, 0); PG8_LDB(B1, 1, 1); PG8_SCHED; PG8_LDA(At, 1, 0); PG8_STAGE(PG8_SA(0, 1), a2 + hstepA, voffA);
            PG8_WAIT_V(8); PG8_WAIT_L(0); PG8_BAR; PG8_MMA(0, 0, At, B0); PG8_MMA(0, 1, At, B1); PG8_BAR; PG8_SCHED;
            PG8_LDA(At, 1, 1); PG8_STAGE(PG8_SB(1, 0), b3, voffB); PG8_STAGE(PG8_SB(1, 1), b3 + hstepB, voffB); PG8_STAGE(PG8_SA(1, 0), a3, voffA);
            PG8_WAIT_V(8); PG8_WAIT_L(0); PG8_BAR; PG8_MMA(1, 0, At, B0); PG8_MMA(1, 1, At, B1); PG8_BAR; PG8_SCHED;
            } else {
            PG8_LDB(B0, 0, 0); PG8_SCHED; PG8_LDA(At, 0, 0); PG8_STAGE(PG8_SA(1, 1), a1 + hstepA, voffA);
            PG8_WAIT_L(8); PG8_BAR; PG8_WAIT_L(0); PG8_MMA(0, 0, At, B0); PG8_BAR; PG8_SCHED;
            PG8_LDB(B1, 0, 1); PG8_STAGE(PG8_SB(0, 0), b2, voffB);
            PG8_BAR; PG8_WAIT_L(0); PG8_MMA(0, 1, At, B1); PG8_BAR;
            PG8_LDA(At, 0, 1); PG8_STAGE(PG8_SA(0, 0), a2, voffA);
            PG8_BAR; PG8_WAIT_L(0); PG8_MMA(1, 0, At, B0); PG8_BAR; PG8_SCHED;
            PG8_STAGE(PG8_SB(0, 1), b2 + hstepB, voffB);
            PG8_WAIT_V(6); PG8_BAR; PG8_MMA(1, 1, At, B1); PG8_BAR;
            PG8_LDB(B0, 1, 0); PG8_SCHED; PG8_LDA(At, 1, 0); PG8_STAGE(PG8_SA(0, 1), a2 + hstepA, voffA);
            PG8_WAIT_L(8); PG8_BAR; PG8_WAIT_L(0); PG8_MMA(0, 0, At, B0); PG8_BAR; PG8_SCHED;
            PG8_LDB(B1, 1, 1); PG8_STAGE(PG8_SB(1, 0), b3, voffB);
            PG8_BAR; PG8_WAIT_L(0); PG8_MMA(0, 1, At, B1); PG8_BAR;
            PG8_LDA(At, 1, 1); PG8_STAGE(PG8_SA(1, 0), a3, voffA);
            PG8_BAR; PG8_WAIT_L(0); PG8_MMA(1, 0, At, B0); PG8_BAR; PG8_SCHED;
            PG8_STAGE(PG8_SB(1, 1), b3 + hstepB, voffB);
            PG8_WAIT_V(6); PG8_BAR; PG8_MMA(1, 1, At, B1); PG8_BAR;
            }
        }
        if constexpr (ALIGN_EPI) { if (wr == 0) PG8_BAR; }
        if constexpr (!Epi::AFTER_DRAIN) { if constexpr (Epi::HAS_PRE) E(acc, cur, wr, wc, fr, fq, pre, lds, tid); else E(acc, cur, wr, wc, fr, fq); S.done(cur); }
        if (!has_next) break;
#pragma unroll
        for (int a = 0; a < 2; ++a)
#pragma unroll
            for (int b = 0; b < 2; ++b)
#pragma unroll
                for (int m = 0; m < 4; ++m)
#pragma unroll
                    for (int n = 0; n < 2; ++n) acc[a][b][m][n] = (f32x4){0.f, 0.f, 0.f, 0.f};
        cur = nxt; cA = nA; cB = nB; ++ui;
        if constexpr (Epi::HAS_PRE) pre = E.prefetch(cur, tid);
        if constexpr (ALIGN_EPI) { if (wr == 1) PG8_BAR; }
    }
    PG8_WAIT_V(0);
    if constexpr (!ALIGN_EPI) { if (wr == 0) PG8_BAR; }
    PG8_BAR;
    if constexpr (Epi::AFTER_DRAIN) { E.fused(acc, cur, wr, wc, fr, fq, lds, wid, lane); S.done(cur); }
#undef PG8_SA
#undef PG8_SB
#undef PG8_STAGE
#undef PG8_LDA
#undef PG8_LDB
#undef PG8_MMA
#undef PG8_WAIT_V
#undef PG8_WAIT_L
#undef PG8_BAR
#undef PG8_SCHED
}
}

#ifndef PG8_SP2
#define PG8_SP2 true
#endif
#ifndef PG8_ALIGN
#define PG8_ALIGN true
#endif

constexpr int NWAVES = 8, NTHR = 512;
constexpr int DM = 2048, TSEQ = 4096, NBATCH = 2, MP = NBATCH * TSEQ, SB = 8, ST = 4, MS = SB * ST, MT = MP + MS, DEPTH = 4;
constexpr int NQKV = 9216, AW = 1024, FF2 = 12288, FF = 6144;
constexpr float RMS_EPS = 1e-6f;
enum { I_XP = 0, I_XS, I_C128, I_C512, I_C2048, I_SLH, I_SLC, I_SFC, I_NMIX, I_NFFN, I_NFIN, I_LWIN, I_LBIN, I_LCW, I_LCB, I_LWA, I_LBA, I_LWI, I_LBI, I_LLAM, I_LWOUT, I_LBOUT, I_AWQKV, I_AWO, I_FWUP, I_FCW, I_FCB, I_FWDN, N_IN };
constexpr size_t O_YP = 0, O_YS = O_YP + (size_t)MP * DM, O_KVP0 = O_YS + (size_t)MS * DM, O_KVP1 = O_KVP0 + (size_t)2 * 2 * 128 * 2048, O_KVP2 = O_KVP1 + (size_t)2 * 2 * 512 * 2048,
                 O_LHP = O_KVP2 + (size_t)2 * 2 * 2048 * 2048, O_LCP = O_LHP + (size_t)2 * 2 * 2048, O_FCP = O_LCP + (size_t)2 * 2 * 3 * 2048, O_KVS0 = O_FCP + (size_t)4 * 2 * 2 * FF2,
                 O_KVS1 = O_KVS0 + (size_t)2 * 8 * 4 * 2048, O_KVS2 = O_KVS1 + (size_t)2 * 8 * 4 * 2048, O_LHS = O_KVS2 + (size_t)2 * 8 * 4 * 2048, O_LCS = O_LHS + (size_t)2 * 8 * 2048,
                 O_FCS = O_LCS + (size_t)2 * 8 * 3 * 2048, O_END = O_FCS + (size_t)4 * 8 * 2 * FF2;
static_assert(O_END == 40402944, "output size");

constexpr size_t MiB = 1u << 20;
constexpr size_t WS_CTL = 0, CTL_ZERO_BYTES = 32 * 1024;
constexpr size_t WS_MISC = 1 * MiB;
constexpr size_t WS_WIN = 2 * MiB;
constexpr size_t WS_WOUT = WS_WIN + 32 * MiB;
constexpr size_t WS_GT = WS_WOUT + 16 * MiB;
constexpr size_t WS_WQKV = WS_GT + 4 * MiB;
constexpr size_t WS_WO = WS_WQKV + 72 * MiB;
constexpr size_t WS_WUP = WS_WO + 8 * MiB;
constexpr size_t WS_WDN = WS_WUP + 192 * MiB;
constexpr size_t WS_X = WS_WDN + 96 * MiB;
constexpr size_t WS_XN = WS_X + 65 * MiB;
constexpr size_t WS_SC = WS_XN + 33 * MiB;
constexpr size_t WS_S = WS_SC + 3 * MiB;
constexpr size_t S_GG = 0, S_U = 33 * MiB, S_UC = 66 * MiB, S_HG = 99 * MiB, S_LA = 132 * MiB, S_GI = 197 * MiB;
constexpr size_t S_QKV = 0, S_OG = 145 * MiB, S_LSE = 242 * MiB, S_O = 243 * MiB;
constexpr size_t S_UPS = 0, S_HB = 1 * MiB, S_ACT = 193 * MiB;
constexpr size_t WS_SSP = WS_S + 290 * MiB;
constexpr size_t WS_SSS = WS_SSP + 3 * MiB;
constexpr size_t WS_END = WS_SSS + 1 * MiB;
static_assert((size_t)MT * NQKV * 2 <= 145 * MiB && (size_t)3 * MT * AW * 4 <= 97 * MiB && (size_t)MT * FF * 2 <= 97 * MiB && (size_t)MT * DM * 4 <= 65 * MiB && (size_t)MT * DM * 2 <= 33 * MiB, "d_ws map");
constexpr int CW_TMO = 0, CW_CODE = 1, CW_BAR = 4096;
static_assert((size_t)(CW_BAR + 3456) * 4 <= CTL_ZERO_BYTES, "barrier words inside the per-call memset");

constexpr int RING_OFF = 0, RING_BYTES = 147456;
constexpr int LDSCTL_OFF = RING_BYTES, MISC_OFF = LDSCTL_OFF + 320;
constexpr int LDS_BYTES = 148480;
constexpr int EPI_T_OFF = 131072;
static_assert(MISC_OFF + 128 <= LDS_BYTES, "LDS map");

#define GAS __attribute__((address_space(1)))
#define LAS __attribute__((address_space(3)))
typedef unsigned short bf16;
typedef unsigned v4u __attribute__((ext_vector_type(4)));
typedef unsigned v2u __attribute__((ext_vector_type(2)));
typedef float f32x4 __attribute__((ext_vector_type(4)));
typedef float f32x2 __attribute__((ext_vector_type(2)));
typedef short bf16x8 __attribute__((ext_vector_type(8)));
typedef GAS unsigned gu32;
#define RLX_AGENT __ATOMIC_RELAXED, __HIP_MEMORY_SCOPE_AGENT
#define LDS_WAIT() asm volatile("s_waitcnt lgkmcnt(0)" ::: "memory")
#define VM_WAIT() asm volatile("s_waitcnt vmcnt(0)" ::: "memory")
using pg8::cvt_pk_bf16; using pg8::gelu_tanh; using pg8::sigmoid_f; using pg8::bf_lo; using pg8::bf_hi;
__device__ __forceinline__ bf16 f2bf1(float f) { return (bf16)(cvt_pk_bf16(f, 0.f) & 0xffffu); }
__device__ __forceinline__ float bf2f(bf16 b) { return __uint_as_float((unsigned)b << 16); }
__device__ __forceinline__ void unpack8(const v4u w, float (&f)[8]) { f[0] = bf_lo(w.x); f[1] = bf_hi(w.x); f[2] = bf_lo(w.y); f[3] = bf_hi(w.y); f[4] = bf_lo(w.z); f[5] = bf_hi(w.z); f[6] = bf_lo(w.w); f[7] = bf_hi(w.w); }
__device__ __forceinline__ v4u pack8(const float (&f)[8]) { v4u w; w.x = cvt_pk_bf16(f[0], f[1]); w.y = cvt_pk_bf16(f[2], f[3]); w.z = cvt_pk_bf16(f[4], f[5]); w.w = cvt_pk_bf16(f[6], f[7]); return w; }
__device__ __forceinline__ void load8f(const float* p, float (&f)[8]) { const f32x4 a = *(const f32x4*)p, b = *(const f32x4*)(p + 4); f[0] = a[0]; f[1] = a[1]; f[2] = a[2]; f[3] = a[3]; f[4] = b[0]; f[5] = b[1]; f[6] = b[2]; f[7] = b[3]; }
__device__ __forceinline__ void store8f(float* p, const float (&f)[8]) { *(f32x4*)p = (f32x4){f[0], f[1], f[2], f[3]}; *(f32x4*)(p + 4) = (f32x4){f[4], f[5], f[6], f[7]}; }
using pg8::xshf; using pg8::half_sum; using pg8::half_max; using pg8::rstd_ss; using pg8::rstd_row8;
__device__ __forceinline__ float wave_sum(float v) { v += xshf<1>(v); v += xshf<2>(v); v += xshf<4>(v); v += xshf<8>(v); v += xshf<16>(v); return half_sum(v); }
__device__ __forceinline__ float wave_max(float v) { v = fmaxf(v, xshf<1>(v)); v = fmaxf(v, xshf<2>(v)); v = fmaxf(v, xshf<4>(v)); v = fmaxf(v, xshf<8>(v)); v = fmaxf(v, xshf<16>(v)); return half_max(v); }
__device__ __forceinline__ int lane_id() { int l; asm volatile("v_mbcnt_lo_u32_b32 %0, -1, 0\n\tv_mbcnt_hi_u32_b32 %0, -1, %0" : "=v"(l)); return l; }
#define XB_TMO      128
#define XB_XCNT(j)  (256  + 64 * (j))
#define XB_XSUB(j)  (1280 + 64 * (j))
#define XB_XGEN(j)  (2304 + 64 * (j))
#define XB_TOP      3328
#define XB_TOPGEN   3392
#define XCD_BAR_WORDS 3456
#define XB_SPIN_CAP (1u << 18)

__device__ __forceinline__ unsigned xb_ld(unsigned* p)              { return __hip_atomic_load(p, __ATOMIC_RELAXED, __HIP_MEMORY_SCOPE_AGENT); }
__device__ __forceinline__ unsigned xb_add(unsigned* p, unsigned v) { return __hip_atomic_fetch_add(p, v, __ATOMIC_RELAXED, __HIP_MEMORY_SCOPE_AGENT); }
__device__ __forceinline__ unsigned xb_xcc_id() { return (unsigned)__builtin_amdgcn_s_getreg((3 << 11) | 20) & 0xFu; }
#define XB_SPIN(cond, bar) do { unsigned _sp = 0; while (cond) { __builtin_amdgcn_s_sleep(1); \
    if ((++_sp & 255u) == 0u) { if (xb_ld(&(bar)[XB_TMO])) break; if (_sp > XB_SPIN_CAP) { atomicAdd(&(bar)[XB_TMO], 1u); break; } } } } while (0)

struct XcdBarrier {
    unsigned* bar; unsigned x; int wv;
    volatile LAS unsigned* st;
};

__device__ __forceinline__ bool xb_thread0(int wv) { return wv == 0 && lane_id() == 0; }
__device__ __forceinline__ XcdBarrier xcd_barrier_post(unsigned* bar, volatile LAS unsigned* st, int wv) {
    XcdBarrier b; b.bar = bar; b.x = xb_xcc_id(); b.st = st; b.wv = wv;
    if (xb_thread0(wv)) (void)xb_add(&bar[XB_XCNT(b.x)], 1u);
    return b;
}
__device__ __forceinline__ void xcd_barrier_complete(unsigned* bar, unsigned x, unsigned& nloc, unsigned& nx) {
    const unsigned G = gridDim.x * gridDim.y * gridDim.z;
    unsigned sum, cnt, mine, sp = 0u;
    for (;;) {
        sum = 0u; cnt = 0u; mine = 0u;
#pragma unroll
        for (unsigned j = 0; j < 16; ++j) { const unsigned c = xb_ld(&bar[XB_XCNT(j)]); sum += c; cnt += (c > 0u) ? 1u : 0u; mine = (j == x) ? c : mine; }
        if (sum == G) break;
        __builtin_amdgcn_s_sleep(1);
        if ((++sp & 255u) == 0u) { if (xb_ld(&bar[XB_TMO])) break; if (sp > XB_SPIN_CAP) { atomicAdd(&bar[XB_TMO], 1u); break; } }
    }
    nloc = mine > 0u ? mine : 1u; nx = cnt > 0u ? cnt : 1u;
}

__device__ __forceinline__ void xcd_barrier(const XcdBarrier& b) {
    asm volatile("s_waitcnt vmcnt(0)" ::: "memory");
    __syncthreads();
    if (xb_thread0(b.wv)) {
        unsigned* bar = b.bar;
        __builtin_amdgcn_s_waitcnt(0);
        unsigned nloc = b.st[0], nx = b.st[1];
        if (nloc == 0u) { xcd_barrier_complete(bar, b.x, nloc, nx); b.st[0] = nloc; b.st[1] = nx; }
        const unsigned old = xb_add(&bar[XB_XSUB(b.x)], 1u);
        const unsigned gen = old / nloc;
        if (old + 1u == (gen + 1u) * nloc) {
            __builtin_amdgcn_fence(__ATOMIC_RELEASE, "agent");
            asm volatile("s_waitcnt vmcnt(0)" ::: "memory");
            const unsigned og = xb_add(&bar[XB_TOP], 1u);
            const unsigned tg = og / nx;
            if (og + 1u == (tg + 1u) * nx) xb_add(&bar[XB_TOPGEN], 1u);
            else XB_SPIN(xb_ld(&bar[XB_TOPGEN]) == tg, bar);
            __builtin_amdgcn_fence(__ATOMIC_ACQUIRE, "agent");
            xb_add(&bar[XB_XGEN(b.x)], 1u);
            asm volatile("s_waitcnt vmcnt(0)" ::: "memory");
        } else {
            XB_SPIN(xb_ld(&bar[XB_XGEN(b.x)]) == gen, bar);
            __builtin_amdgcn_fence(__ATOMIC_ACQUIRE, "agent");
            asm volatile("s_waitcnt vmcnt(0)" ::: "memory");
        }
    }
    __syncthreads();
}

struct Args { const float* in[N_IN]; float* out; unsigned char* ws; };
typedef __attribute__((address_space(4))) const Args CArgs;
__device__ __forceinline__ CArgs* kargs() { CArgs* p = (CArgs*)__builtin_amdgcn_kernarg_segment_ptr(); asm volatile("" : "+s"(p)); return p; }
struct Frame {
    LAS unsigned char* lds;
    int tid, lane, wave, G, bx;
    int gw, ngw, gt, ngt;
};

__device__ __forceinline__ Frame mk_frame(LAS unsigned char* lds, int wv) {
    Frame F; asm volatile("" : "+s"(wv)); const int lane = lane_id(); const int tid = wv * 64 + lane;
    F.lds = lds; F.tid = tid; F.lane = lane; F.wave = wv;
    int G_ = gridDim.x, bx_ = blockIdx.x; asm volatile("" : "+s"(G_), "+s"(bx_)); F.G = G_; F.bx = bx_;
    F.gw = F.bx * NWAVES + F.wave; F.ngw = F.G * NWAVES; F.gt = F.bx * NTHR + tid; F.ngt = F.G * NTHR;
    return F;
}

template <int GLU = 0>
__device__ __forceinline__ void p0_transpose_item(const float* W, int K, int N, bf16* WT, LAS float* scr, int item, int lane, const float* gain = nullptr) {
    const int nblk = N / 32, kb = item / nblk, nb = item % nblk, k0 = 128 * kb, n0 = 32 * nb;
    const int nd0 = GLU ? (n0 < 6144 ? 256 * (n0 >> 7) + (n0 & 127) : 256 * ((n0 - 6144) >> 7) + 128 + ((n0 - 6144) & 127)) : n0;
#pragma unroll 32
    for (int i = 0; i < 64; ++i) { const int kk = 2 * i + (lane >> 5); scr[kk * 33 + (lane & 31)] = W[(size_t)(k0 + kk) * N + n0 + (lane & 31)]; }
    LDS_WAIT(); asm volatile("" ::: "memory");
    const int c = lane & 15;
    float gk[8];
    if (gain) load8f(gain + k0 + 8 * c, gk); else {
#pragma unroll
        for (int e = 0; e < 8; ++e) gk[e] = 1.0f; }
#pragma unroll
    for (int j = 0; j < 8; ++j) { const int n = (lane >> 4) + 4 * j; const LAS float* s = scr + (8 * c) * 33 + n;
        v4u o; o.x = cvt_pk_bf16(s[0 * 33] * gk[0], s[1 * 33] * gk[1]); o.y = cvt_pk_bf16(s[2 * 33] * gk[2], s[3 * 33] * gk[3]); o.z = cvt_pk_bf16(s[4 * 33] * gk[4], s[5 * 33] * gk[5]); o.w = cvt_pk_bf16(s[6 * 33] * gk[6], s[7 * 33] * gk[7]);
        *(GAS v4u*)(WT + (size_t)(nd0 + n) * K + k0 + 8 * c) = o; }
    LDS_WAIT(); asm volatile("" ::: "memory");
}
__device__ __forceinline__ void rows_to_bf16_ss(const Frame& F, const float* xp, const float* xs, bf16* XB, float* SSP, float* SSS) {
#pragma unroll 2
    for (int m = F.gw; m < MT; m += F.ngw) {
        const float* src = (m < MP) ? xp + (size_t)m * DM : xs + (size_t)(m - MP) * DM;
        const GAS f32x4* xr = (const GAS f32x4*)src + F.lane;
        f32x4 v[8]; float s = 0.f;
#pragma unroll
        for (int j = 0; j < 8; ++j) { v[j] = xr[64 * j]; s += (v[j].x * v[j].x + v[j].y * v[j].y) + (v[j].z * v[j].z + v[j].w * v[j].w); }
        s = wave_sum(s);
        GAS v2u* o8 = (GAS v2u*)(XB + (size_t)m * DM) + F.lane;
#pragma unroll
        for (int j = 0; j < 8; ++j) { v2u w; w.x = cvt_pk_bf16(v[j].x, v[j].y); w.y = cvt_pk_bf16(v[j].z, v[j].w); o8[64 * j] = w; }
        if (m < MP) { if (F.lane < 8) SSP[(size_t)m * 8 + F.lane] = F.lane == 0 ? s : 0.f; } else { *(f32x2*)(SSS + (size_t)(m - MP) * 128 + 2 * F.lane) = (f32x2){F.lane == 0 ? s : 0.f, 0.f}; }
    }
}
__device__ __forceinline__ void norm_rows_out(const Frame& F, const bf16* XB, const float* g, float* yp, float* ys) {
#pragma unroll 2
    for (int m = F.gw; m < MT; m += F.ngw) {
        const GAS v4u* xr = (const GAS v4u*)(XB + (size_t)m * DM) + F.lane;
        float v[4][8]; float s = 0.f;
#pragma unroll
        for (int j = 0; j < 4; ++j) { unpack8(xr[64 * j], v[j]);
#pragma unroll
            for (int e = 0; e < 8; ++e) s += v[j][e] * v[j][e]; }
        const float rstd = __builtin_amdgcn_rsqf(wave_sum(s) * (1.0f / DM) + RMS_EPS);
        float* dst = (m < MP) ? yp + (size_t)m * DM : ys + (size_t)(m - MP) * DM;
#pragma unroll
        for (int j = 0; j < 4; ++j) { float gg[8], o[8]; load8f(g + 512 * j + 8 * F.lane, gg);
#pragma unroll
            for (int e = 0; e < 8; ++e) o[e] = v[j][e] * rstd * gg[e];
            store8f(dst + 512 * j + 8 * F.lane, o); }
    }
}

__device__ __forceinline__ void p0_prologue(const Frame& F, CArgs* A, unsigned char* ws) {
    LAS float* scr = (LAS float*)(F.lds + RING_OFF + F.wave * 17408);
    bf16* WIN = (bf16*)(ws + WS_WIN); bf16* WOUT = (bf16*)(ws + WS_WOUT); bf16* GT = (bf16*)(ws + WS_GT); bf16* WQKV = (bf16*)(ws + WS_WQKV);
    bf16* WO = (bf16*)(ws + WS_WO); bf16* WUP = (bf16*)(ws + WS_WUP); bf16* WDN = (bf16*)(ws + WS_WDN);
    constexpr int IP_UP = (DM / 128) * (FF2 / 32), IP_DN = (FF / 128) * (DM / 32), IP_QKV = (DM / 128) * (NQKV / 32), IP_IN = (DM / 128) * (4096 / 32), IP_OUT = (DM / 128) * (DM / 32), IP_WO = (AW / 128) * (DM / 32), IP_G = (256 / 128) * (256 / 32);
    constexpr int NITEMS = 4 * IP_UP + 4 * IP_DN + 2 * IP_QKV + 2 * IP_IN + 2 * IP_OUT + 2 * IP_WO + 32 * IP_G;
#define P0_SEG(COUNT, IPM, CALL) if (r < (COUNT) * (IPM)) { const int mi = r / (IPM), item = r % (IPM); (void)mi; CALL; continue; } r -= (COUNT) * (IPM);
#define P0_UP(mat) p0_transpose_item<1>(A->in[I_FWUP] + (size_t)(mat) * DM * FF2, DM, FF2, WUP + (size_t)(mat) * DM * FF2, scr, item, F.lane, A->in[I_NFFN] + (size_t)(mat) * DM)
#define P0_DN(mat) p0_transpose_item(A->in[I_FWDN] + (size_t)(mat) * DM * FF, FF, DM, WDN + (size_t)(mat) * DM * FF, scr, item, F.lane)
#define P0_QKV(mat) p0_transpose_item(A->in[I_AWQKV] + (size_t)(mat) * DM * NQKV, DM, NQKV, WQKV + (size_t)(mat) * DM * NQKV, scr, item, F.lane, A->in[I_NMIX] + (size_t)(2 * (mat) + 1) * DM)
#define P0_IN(mat) p0_transpose_item(A->in[I_LWIN] + (size_t)(mat) * DM * 4096, DM, 4096, WIN + (size_t)(mat) * DM * 4096, scr, item, F.lane, A->in[I_NMIX] + (size_t)(2 * (mat)) * DM)
#define P0_OUT(mat) p0_transpose_item(A->in[I_LWOUT] + (size_t)(mat) * DM * DM, DM, DM, WOUT + (size_t)(mat) * DM * DM, scr, item, F.lane)
#define P0_WO(mat) p0_transpose_item(A->in[I_AWO] + (size_t)(mat) * AW * DM, AW, DM, WO + (size_t)(mat) * AW * DM, scr, item, F.lane)
    for (int it = F.gw; it < NITEMS; it += F.ngw) {
        int r = it;
        P0_SEG(3, IP_DN, P0_DN(3 - mi)) P0_SEG(3, IP_UP, P0_UP(3 - mi))
        P0_SEG(1, IP_QKV, P0_QKV(1)) P0_SEG(1, IP_WO, P0_WO(1)) P0_SEG(1, IP_IN, P0_IN(1)) P0_SEG(1, IP_OUT, P0_OUT(1))
        P0_SEG(1, IP_QKV, P0_QKV(0)) P0_SEG(1, IP_WO, P0_WO(0))
        P0_SEG(1, IP_DN, P0_DN(0)) P0_SEG(1, IP_UP, P0_UP(0))
        if (r < 32 * IP_G) { const int gate = r / (16 * IP_G); const int rr = r % (16 * IP_G); const int mat = rr / IP_G;
          p0_transpose_item(A->in[gate ? I_LWI : I_LWA] + (size_t)mat * 65536, 256, 256, GT + (size_t)(mat >> 3) * (4096 * 256) + (size_t)gate * (2048 * 256) + (size_t)(mat & 7) * 65536, scr, rr % IP_G, F.lane); continue; } r -= 32 * IP_G;
        P0_SEG(1, IP_OUT, P0_OUT(0)) P0_SEG(1, IP_IN, P0_IN(0))
    }
    if (F.gt < 2 * 2048) { float* SP = (float*)(ws + WS_MISC); SP[F.gt] = log1pf(expf(-A->in[I_LLAM][F.gt])); }
    rows_to_bf16_ss(F, A->in[I_XP], A->in[I_XS], (bf16*)(ws + WS_XN), (float*)(ws + WS_SSP), (float*)(ws + WS_SSS));
}

template <int NB, int UNR = 8, class Fn>
__device__ __forceinline__ void thin_gemm(const Frame& F, const bf16* A, int lda, int amod, const bf16* Bt, int N, int K, const Fn& fn, const float* sss = nullptr) {
    LAS float* red = (LAS float*)(F.lds + RING_OFF);
    const int fr = F.lane & 15, fq = F.lane >> 4;
    const int kper = K >> 3, k0 = F.wave * kper;
    float rsd = 1.0f;
    if (sss) { const float* p = sss + (size_t)(F.tid >> 4) * 128 + (F.tid & 15) * 8; const f32x4 a = *(const f32x4*)p, b = *(const f32x4*)(p + 4);
        float t = ((a[0] + a[1]) + (a[2] + a[3])) + ((b[0] + b[1]) + (b[2] + b[3])); t += xshf<1>(t); t += xshf<2>(t); t += xshf<4>(t); t += xshf<8>(t); rsd = rstd_ss(t); }
    const int nitems = N / 16; constexpr int nb = NB;
    for (int it0 = F.bx; it0 < nitems; it0 += nb * F.G) {
        const int it1 = it0 + F.G, it2 = it0 + 2 * F.G; const bool v1 = nb > 1 && it1 < nitems, v2 = nb > 1 && it2 < nitems;
        const int n0 = it0 * 16, n1 = (v1 ? it1 : it0) * 16, n2 = (v2 ? it2 : it0) * 16;
        const int acol = amod ? ((n0 >> 8) % amod) * K : 0;
        const bf16* ap0 = A + (size_t)fr * lda + acol + k0 + 8 * fq;
        const bf16* ap1 = ap0 + (size_t)16 * lda;
        const bf16* bp0 = Bt + (size_t)(n0 + fr) * K + k0 + 8 * fq; const bf16* bp1 = Bt + (size_t)(n1 + fr) * K + k0 + 8 * fq; const bf16* bp2 = Bt + (size_t)(n2 + fr) * K + k0 + 8 * fq;
        f32x4 acc[NB][2];
#pragma unroll
        for (int j = 0; j < NB; ++j) { acc[j][0] = (f32x4){0.f, 0.f, 0.f, 0.f}; acc[j][1] = (f32x4){0.f, 0.f, 0.f, 0.f}; }
#pragma unroll UNR
        for (int s = 0; s < kper; s += 32) {
            const bf16x8 a0 = *(const bf16x8*)(ap0 + s), a1 = *(const bf16x8*)(ap1 + s), b0 = *(const bf16x8*)(bp0 + s);
            acc[0][0] = __builtin_amdgcn_mfma_f32_16x16x32_bf16(a0, b0, acc[0][0], 0, 0, 0); acc[0][1] = __builtin_amdgcn_mfma_f32_16x16x32_bf16(a1, b0, acc[0][1], 0, 0, 0);
            if constexpr (NB > 1) { const bf16x8 b1 = *(const bf16x8*)(bp1 + s), b2 = *(const bf16x8*)(bp2 + s);
                acc[1][0] = __builtin_amdgcn_mfma_f32_16x16x32_bf16(a0, b1, acc[1][0], 0, 0, 0); acc[1][1] = __builtin_amdgcn_mfma_f32_16x16x32_bf16(a1, b1, acc[1][1], 0, 0, 0);
                acc[2][0] = __builtin_amdgcn_mfma_f32_16x16x32_bf16(a0, b2, acc[2][0], 0, 0, 0); acc[2][1] = __builtin_amdgcn_mfma_f32_16x16x32_bf16(a1, b2, acc[2][1], 0, 0, 0); }
        }
#pragma unroll
        for (int j = 0; j < NB; ++j)
#pragma unroll
            for (int r = 0; r < 4; ++r) { red[j * 4096 + F.wave * 512 + (4 * fq + r) * 16 + fr] = acc[j][0][r]; red[j * 4096 + F.wave * 512 + (16 + 4 * fq + r) * 16 + fr] = acc[j][1][r]; }
        __syncthreads();
#pragma unroll
        for (int j = 0; j < NB; ++j) { if (j == 0 || (j == 1 && v1) || (j == 2 && v2)) { float v = 0.f;
#pragma unroll
            for (int w = 0; w < 8; ++w) v += red[j * 4096 + w * 512 + F.tid];
            fn(F.tid >> 4, (j == 0 ? n0 : (j == 1 ? n1 : n2)) + (F.tid & 15), v * rsd); } }
        __syncthreads();
    }
}
struct TWin { bf16* GG; bf16* U; const float* bias;
    __device__ __forceinline__ void operator()(int r, int c, float v) const { v += bias[c]; if (c < 2048) GG[(size_t)(MP + r) * 2048 + c] = f2bf1(gelu_tanh(v)); else U[(size_t)(MP + r) * 2048 + c - 2048] = f2bf1(v); } };
struct TGates { bf16* OMA; bf16* GI; const bf16* UC; const float* b_a; const float* b_i; const float* sp;
    __device__ __forceinline__ void operator()(int r, int c, float v) const {
        if (c < 2048) OMA[(size_t)(MP + r) * 2048 + c] = f2bf1(1.0f - __builtin_amdgcn_exp2f(sigmoid_f(v + b_a[c]) * sp[c] * (-8.0f * 1.4426950409f)));
        else { c -= 2048; GI[(size_t)(MP + r) * 2048 + c] = f2bf1(sigmoid_f(v + b_i[c]) * bf2f(UC[(size_t)(MP + r) * 2048 + c])); } } };
struct TResid { bf16* XB; const float* bias; float* SSS;
    __device__ __forceinline__ void operator()(int r, int c, float v) const { const bf16 ob = f2bf1(bf2f(XB[(size_t)r * 2048 + c]) + v + (bias ? bias[c] : 0.f)); XB[(size_t)r * 2048 + c] = ob; const float o = bf2f(ob);
        float ss = o * o; ss += xshf<1>(ss); ss += xshf<2>(ss); ss += xshf<4>(ss); ss += xshf<8>(ss);
        if ((c & 15) == 0) SSS[(size_t)r * 128 + (c >> 4)] = ss; } };
struct TQkv { bf16* QKV; float* kvs0; int j;
    __device__ __forceinline__ void operator()(int r, int c, float v) const {
        QKV[(size_t)r * NQKV + c] = f2bf1(v);
        const int g = c / 3072, rem = c - g * 3072, part = rem >> 10;
        if (part) kvs0[(size_t)g * (O_KVS1 - O_KVS0) + ((size_t)(j * 32 + r) * 2 + (part - 1)) * 1024 + (rem & 1023)] = v; } };
struct TUp { bf16* UPS;
    __device__ __forceinline__ void operator()(int r, int c, float v) const { const int tl = c >> 8, x = c & 255; const int nat = x < 128 ? 128 * tl + x : 6144 + 128 * tl + (x - 128); UPS[(size_t)r * FF2 + nat] = f2bf1(v); } };

__device__ __forceinline__ void lru_conv_own(const Frame& F, CArgs* A, int j, const bf16* U, bf16* UC) {
    const float* cw = A->in[I_LCW] + (size_t)j * 4 * 2048; const float* cb = A->in[I_LCB] + (size_t)j * 2048; const float* st = A->in[I_SLC] + (size_t)j * SB * 3 * 2048;
    for (int P = F.bx; P < 256; P += F.G) {
        const int pm = P >> 3, hd = P & 7, c = hd * 256 + (F.tid & 31) * 8, m0 = pm * 256 + (F.tid >> 5) * 16, t0 = m0 & 4095;
        float w[4][8], bias[8], x3[8], x2[8], x1[8];
#pragma unroll
        for (int k = 0; k < 4; ++k) load8f(cw + (size_t)k * 2048 + c, w[k]);
        load8f(cb + c, bias);
        if (t0 != 0) { unpack8(*(const v4u*)(U + (size_t)(m0 - 3) * 2048 + c), x3); unpack8(*(const v4u*)(U + (size_t)(m0 - 2) * 2048 + c), x2); unpack8(*(const v4u*)(U + (size_t)(m0 - 1) * 2048 + c), x1); }
        else {
#pragma unroll
            for (int e = 0; e < 8; ++e) { x3[e] = 0.f; x2[e] = 0.f; x1[e] = 0.f; } }
#pragma unroll
        for (int r = 0; r < 16; ++r) { float x0[8], o[8]; unpack8(*(const v4u*)(U + (size_t)(m0 + r) * 2048 + c), x0);
#pragma unroll
            for (int e = 0; e < 8; ++e) o[e] = bias[e] + w[0][e] * x3[e] + w[1][e] * x2[e] + w[2][e] * x1[e] + w[3][e] * x0[e];
            *(v4u*)(UC + (size_t)(m0 + r) * 2048 + c) = pack8(o);
            if (t0 + r >= TSEQ - 3) store8f(A->out + O_LCP + ((size_t)(j * 2 + (m0 >> 12)) * 3 + (t0 + r - (TSEQ - 3))) * 2048 + c, x0);
#pragma unroll
            for (int e = 0; e < 8; ++e) { x3[e] = x2[e]; x2[e] = x1[e]; x1[e] = x0[e]; } }
    }
    for (int it = F.bx; it < 256; it += F.G) {
        const int hd = (it >> 4) & 7;
#pragma unroll
        for (int q2 = 0; q2 < 2; ++q2) { const int q = F.tid + 512 * q2, row = q >> 5, c = hd * 256 + (q & 31) * 8, b = row >> 2, t = row & 3; const int m = MP + row;
            float acc[8], x0[8] = {0.f, 0.f, 0.f, 0.f, 0.f, 0.f, 0.f, 0.f}; load8f(cb + c, acc);
#pragma unroll
            for (int k = 0; k < 4; ++k) { const int d = 3 - k; float w[8], x[8]; load8f(cw + (size_t)k * 2048 + c, w);
                if (t >= d) unpack8(*(const v4u*)(U + (size_t)(m - d) * 2048 + c), x); else load8f(st + ((size_t)b * 3 + (t + 3 - d)) * 2048 + c, x);
#pragma unroll
                for (int e = 0; e < 8; ++e) acc[e] += w[e] * x[e];
                if (k == 3) {
#pragma unroll
                    for (int e = 0; e < 8; ++e) x0[e] = x[e]; } }
            *(v4u*)(UC + (size_t)m * 2048 + c) = pack8(acc);
            if (t >= 1) store8f(A->out + O_LCS + ((size_t)(j * SB + b) * 3 + (t - 1)) * 2048 + c, x0); }
    }
    VM_WAIT(); __syncthreads();
}
__device__ __forceinline__ float fsqrt(float x) { return __builtin_amdgcn_sqrtf(x); }
__device__ __forceinline__ void scan_pass1(const Frame& F, const bf16* OMA, const bf16* GI, float* CA, float* CB) {
    for (int it = F.bx; it < 256; it += F.G) {
        const int q = it & 1, ch = (it >> 1) & 63, b = it >> 7, col = q * 1024 + 2 * F.tid;
        const size_t base = ((size_t)b * TSEQ + ch * 64) * 2048 + col;
        float A0 = 1.f, B0 = 0.f, A1 = 1.f, B1 = 0.f;
#pragma nounroll
        for (int r0 = 0; r0 < 64; r0 += 16) {
            unsigned ow[16], gw[16];
#pragma unroll
            for (int k = 0; k < 16; ++k) { ow[k] = *(const unsigned*)(OMA + base + (size_t)(r0 + k) * 2048); gw[k] = *(const unsigned*)(GI + base + (size_t)(r0 + k) * 2048); }
            __builtin_amdgcn_sched_barrier(0);
#pragma unroll
            for (int k = 0; k < 16; ++k) { const float o0 = bf_lo(ow[k]), o1 = bf_hi(ow[k]), a0 = 1.f - o0, a1 = 1.f - o1;
                A0 *= a0; B0 = a0 * B0 + fsqrt(o0 * (1.f + a0)) * bf_lo(gw[k]); A1 *= a1; B1 = a1 * B1 + fsqrt(o1 * (1.f + a1)) * bf_hi(gw[k]); }
        }
        *(f32x2*)(CA + (size_t)(b * 64 + ch) * 2048 + col) = (f32x2){A0, A1}; *(f32x2*)(CB + (size_t)(b * 64 + ch) * 2048 + col) = (f32x2){B0, B1};
    }
}
__device__ __forceinline__ void scan_pass2(const Frame& F, const float* CA, const float* CB, float* HIN) {
    LAS float* T = (LAS float*)(F.lds + RING_OFF);
    const int lc = F.tid & 63, g = F.wave;
    for (int it = F.bx; it < NBATCH * 32; it += F.G) {
        const int b = it >> 5, col = (it & 31) * 64 + lc;
        float a[8], c[8];
#pragma unroll
        for (int k = 0; k < 8; ++k) { const size_t i = (size_t)(b * 64 + g * 8 + k) * 2048 + col; a[k] = CA[i]; c[k] = CB[i]; }
        float Ag = 1.f, Bg = 0.f;
#pragma unroll
        for (int k = 0; k < 8; ++k) { Ag = a[k] * Ag; Bg = a[k] * Bg + c[k]; }
        *(LAS f32x2*)(T + (g * 64 + lc) * 2) = (f32x2){Ag, Bg};
        __syncthreads();
        float h = 0.f;
        for (int gg = 0; gg < g; ++gg) { const f32x2 t = *(const LAS f32x2*)(T + (gg * 64 + lc) * 2); h = t.x * h + t.y; }
#pragma unroll
        for (int k = 0; k < 8; ++k) { const size_t i = (size_t)(b * 64 + g * 8 + k) * 2048 + col; HIN[i] = h; h = a[k] * h + c[k]; }
        __syncthreads();
    }
}
__device__ __forceinline__ void scan_pass3(const Frame& F, CArgs* A, int j, const bf16* OMA, const bf16* GI, const float* HIN, const bf16* GG, bf16* HG) {
    for (int it = F.bx; it < 256; it += F.G) {
        const int q = it & 1, ch = (it >> 1) & 63, b = it >> 7, col = q * 1024 + 2 * F.tid;
        const size_t base = ((size_t)b * TSEQ + ch * 64) * 2048 + col;
        const f32x2 hin = *(const f32x2*)(HIN + (size_t)(b * 64 + ch) * 2048 + col); float h0 = hin.x, h1 = hin.y;
#pragma nounroll
        for (int r0 = 0; r0 < 64; r0 += 16) {
            unsigned ow[16], gw[16], ggw[16];
#pragma unroll
            for (int k = 0; k < 16; ++k) { const size_t i = base + (size_t)(r0 + k) * 2048; ow[k] = *(const unsigned*)(OMA + i); gw[k] = *(const unsigned*)(GI + i); ggw[k] = *(const unsigned*)(GG + i); }
            __builtin_amdgcn_sched_barrier(0);
#pragma unroll
            for (int k = 0; k < 16; ++k) { const size_t i = base + (size_t)(r0 + k) * 2048; const float o0 = bf_lo(ow[k]), o1 = bf_hi(ow[k]), a0 = 1.f - o0, a1 = 1.f - o1;
                h0 = a0 * h0 + fsqrt(o0 * (1.f + a0)) * bf_lo(gw[k]); h1 = a1 * h1 + fsqrt(o1 * (1.f + a1)) * bf_hi(gw[k]);
                *(unsigned*)(HG + i) = cvt_pk_bf16(h0 * bf_lo(ggw[k]), h1 * bf_hi(ggw[k])); }
        }
        if (ch == 63) *(f32x2*)(A->out + O_LHP + (size_t)(j * 2 + b) * 2048 + col) = (f32x2){h0, h1};
    }
    for (int i = F.gt; i < SB * 2048; i += F.ngt) { const int b = i >> 11, col = i & 2047; float h = A->in[I_SLH][(size_t)(j * SB + b) * 2048 + col];
#pragma unroll
        for (int t = 0; t < ST; ++t) { const size_t k = (size_t)(MP + b * ST + t) * 2048 + col; const float o = bf2f(OMA[k]), a = 1.f - o; h = a * h + fsqrt(o * (1.f + a)) * bf2f(GI[k]); HG[k] = f2bf1(h * bf2f(GG[k])); }
        A->out[O_LHS + (size_t)(j * SB + b) * 2048 + col] = h; }
}
__device__ __forceinline__ void ffn_fix(const Frame& F, CArgs* A, int layer, const bf16* HB, const bf16* UPS, bf16* ACT) {
    const float* cw = A->in[I_FCW] + (size_t)layer * 3 * FF2; const float* cb = A->in[I_FCB] + (size_t)layer * FF2; const float* st = A->in[I_SFC] + (size_t)layer * SB * 2 * FF2;
    constexpr int NSLAB = MP / 64;
    for (int idx = F.gt; idx < (NSLAB + SB) * 768; idx += F.ngt) {
        const int rb = idx / 768, c = (idx - rb * 768) * 8; const bool is_s = rb >= NSLAB;
        f32x4 wq[3][4], bq[4];
#pragma unroll
        for (int k = 0; k < 3; ++k) { wq[k][0] = *(const f32x4*)(cw + (size_t)k * FF2 + c); wq[k][1] = *(const f32x4*)(cw + (size_t)k * FF2 + c + 4); wq[k][2] = *(const f32x4*)(cw + (size_t)k * FF2 + FF + c); wq[k][3] = *(const f32x4*)(cw + (size_t)k * FF2 + FF + c + 4); }
        bq[0] = *(const f32x4*)(cb + c); bq[1] = *(const f32x4*)(cb + c + 4); bq[2] = *(const f32x4*)(cb + FF + c); bq[3] = *(const f32x4*)(cb + FF + c + 4);
        float g2[8], g1[8], v2[8], v1[8];
        if (!is_s) {
            const int s = rb; const bf16* hb = HB + (size_t)s * 4 * FF2 + c; const bool first = (s & 63) == 0, lastslab = (s & 63) == 63;
            v4u hg[4], hv[4];
            const bf16* hp = first ? hb : hb - 2 * FF2;
            hg[0] = *(const v4u*)(hp); hg[1] = *(const v4u*)(hp + FF2); hv[0] = *(const v4u*)(hp + FF); hv[1] = *(const v4u*)(hp + FF2 + FF);
            hg[2] = *(const v4u*)(hb); hg[3] = *(const v4u*)(hb + FF2); hv[2] = *(const v4u*)(hb + FF); hv[3] = *(const v4u*)(hb + FF2 + FF);
            v4u tg[2], tv[2];
            if (lastslab) { tg[0] = *(const v4u*)(hb + (size_t)2 * FF2); tg[1] = *(const v4u*)(hb + (size_t)3 * FF2); tv[0] = *(const v4u*)(hb + (size_t)2 * FF2 + FF); tv[1] = *(const v4u*)(hb + (size_t)3 * FF2 + FF); }
            __builtin_amdgcn_sched_barrier(0);
            unpack8(hg[0], g2); unpack8(hg[1], g1); unpack8(hv[0], v2); unpack8(hv[1], v1);
            if (first) {
#pragma unroll
                for (int e = 0; e < 8; ++e) { g2[e] = 0.f; g1[e] = 0.f; v2[e] = 0.f; v1[e] = 0.f; } }
#pragma unroll
            for (int r = 0; r < 2; ++r) { float ug[8], uv[8], o[8]; unpack8(hg[2 + r], ug); unpack8(hv[2 + r], uv);
#pragma unroll
                for (int e = 0; e < 8; ++e) { const float gg = bq[e >> 2][e & 3] + wq[0][e >> 2][e & 3] * g2[e] + wq[1][e >> 2][e & 3] * g1[e] + wq[2][e >> 2][e & 3] * ug[e];
                    const float vv = bq[2 + (e >> 2)][e & 3] + wq[0][2 + (e >> 2)][e & 3] * v2[e] + wq[1][2 + (e >> 2)][e & 3] * v1[e] + wq[2][2 + (e >> 2)][e & 3] * uv[e]; o[e] = gelu_tanh(gg) * vv; }
                *(v4u*)(ACT + (size_t)(s * 64 + r) * FF + c) = pack8(o);
#pragma unroll
                for (int e = 0; e < 8; ++e) { g2[e] = g1[e]; g1[e] = ug[e]; v2[e] = v1[e]; v1[e] = uv[e]; } }
            if (lastslab) {
#pragma unroll
                for (int r = 0; r < 2; ++r) { float ug[8], uv[8]; unpack8(tg[r], ug); unpack8(tv[r], uv);
                    float* dst = A->out + O_FCP + ((size_t)(layer * 2 + (s >> 6)) * 2 + r) * FF2 + c; store8f(dst, ug); store8f(dst + FF, uv); } }
        } else {
            const int sb = rb - NSLAB;
            f32x4 sq[2][4]; v4u ug4[ST], uv4[ST];
#pragma unroll
            for (int r = 0; r < 2; ++r) { const float* sp = st + ((size_t)sb * 2 + r) * FF2 + c; sq[r][0] = *(const f32x4*)sp; sq[r][1] = *(const f32x4*)(sp + 4); sq[r][2] = *(const f32x4*)(sp + FF); sq[r][3] = *(const f32x4*)(sp + FF + 4); }
#pragma unroll
            for (int r = 0; r < ST; ++r) { const bf16* up = UPS + (size_t)(sb * ST + r) * FF2 + c; ug4[r] = *(const v4u*)up; uv4[r] = *(const v4u*)(up + FF); }
            __builtin_amdgcn_sched_barrier(0);
#pragma unroll
            for (int e = 0; e < 8; ++e) { g2[e] = sq[0][e >> 2][e & 3]; g1[e] = sq[1][e >> 2][e & 3]; v2[e] = sq[0][2 + (e >> 2)][e & 3]; v1[e] = sq[1][2 + (e >> 2)][e & 3]; }
#pragma unroll
            for (int r = 0; r < ST; ++r) { float ug[8], uv[8], o[8]; unpack8(ug4[r], ug); unpack8(uv4[r], uv);
#pragma unroll
                for (int e = 0; e < 8; ++e) { const float gg = bq[e >> 2][e & 3] + wq[0][e >> 2][e & 3] * g2[e] + wq[1][e >> 2][e & 3] * g1[e] + wq[2][e >> 2][e & 3] * ug[e];
                    const float vv = bq[2 + (e >> 2)][e & 3] + wq[0][2 + (e >> 2)][e & 3] * v2[e] + wq[1][2 + (e >> 2)][e & 3] * v1[e] + wq[2][2 + (e >> 2)][e & 3] * uv[e]; o[e] = gelu_tanh(gg) * vv; }
                *(v4u*)(ACT + (size_t)(MP + sb * ST + r) * FF + c) = pack8(o);
                if (r >= 2) { float* dst = A->out + O_FCS + ((size_t)(layer * SB + sb) * 2 + (r - 2)) * FF2 + c; store8f(dst, ug); store8f(dst + FF, uv); }
#pragma unroll
                for (int e = 0; e < 8; ++e) { g2[e] = g1[e]; g1[e] = ug[e]; v2[e] = v1[e]; v1[e] = uv[e]; } }
        }
    }
}
constexpr int ATT_K_OFF = 0, ATT_V_OFF = 65536, ATT_S_OFF = 131072;
__device__ __forceinline__ void attn_decode(int tile, int& b, int& g, int& h, int& dil, int& p, int& n) {
    const int idx32 = tile & 31, bgh = tile >> 5; h = bgh & 7; g = (bgh >> 3) % 3; b = bgh / 24;
    dil = g == 0 ? 1 : (g == 1 ? 4 : 16); const int nb = 32 / dil; p = idx32 / nb; n = idx32 - p * nb;
}
#define ATT_PREFETCH_BLK(kbase_, blk_) do { const bf16* ks_ = (kbase_) + (size_t)((blk_) * 128 + kq) * 128 + ch * 8; \
        _Pragma("unroll") for (int i = 0; i < 4; ++i) { kraw[i] = *(const v4u*)(ks_ + (size_t)i * 32 * 128); vraw[i] = *(const v4u*)(ks_ + (size_t)i * 32 * 128 + (size_t)8 * 2 * 4096 * 128); } } while (0)
#define ATT_PREFETCH_Q(qbase_, blk_) do { const bf16* qb_ = (qbase_) + (size_t)((blk_) * 128 + 16 * w + fr) * 128 + 8 * fq; \
        _Pragma("unroll") for (int ks = 0; ks < 4; ++ks) bq[ks] = *(const bf16x8*)(qb_ + 32 * ks); } while (0)
typedef short att_v4i16 __attribute__((ext_vector_type(4)));
__device__ __forceinline__ void attn_prompt(const Frame& F, const bf16* QKV, bf16* OG, float* LSE) {
    LAS unsigned char* Kl = F.lds + RING_OFF + ATT_K_OFF;
    LAS unsigned char* Vl = F.lds + RING_OFF + ATT_V_OFF;
    const int w = F.wave;
    v4u kraw[4], vraw[4]; bf16x8 bq[4];
    for (int run = F.bx; run < 512; run += F.G) {
        int g, b, h, p, n0, nt;
        if (run < 256) { const int a = run & 127; g = run >> 7; b = a >> 6; h = (a >> 3) & 7; if (g == 0) { p = 0; n0 = 4 * (a & 7); } else { p = (a >> 1) & 3; n0 = 4 * (a & 1); } nt = 4; }
        else { const int c = run - 256; g = 2; b = c >> 7; h = (c >> 4) & 7; p = c & 15; n0 = 0; nt = 2; }
        const int dil = 1 << (2 * g), Lp = TSEQ >> (2 * g);
        const float slope = exp2f(-8.0f * (float)(g * 8 + h + 1) / 24.0f);
        const bf16* kbase = QKV + ((size_t)((g * 3 + 1) * 8 + h) * 2 + b) * (4096 * 128) + (size_t)(p * Lp) * 128;
        const bf16* qbase = QKV + ((size_t)((g * 3 + 0) * 8 + h) * 2 + b) * (4096 * 128) + (size_t)(p * Lp) * 128;
        const size_t orow0 = (size_t)g * MT + (size_t)b * TSEQ;
        { int lane_ = F.lane; asm volatile("" : "+v"(lane_)); const int kq = w * 4 + (lane_ >> 4), ch = lane_ & 15;
          if (n0 > 0) ATT_PREFETCH_BLK(kbase, n0 - 1); else {
#pragma unroll
              for (int i = 0; i < 4; ++i) { kraw[i] = (v4u){0u, 0u, 0u, 0u}; vraw[i] = (v4u){0u, 0u, 0u, 0u}; } } }
        for (int s = -1; s < nt; ++s) {
            const int n = n0 + s;
            int lane_ = F.lane; asm volatile("" : "+v"(lane_));
            const int fr = lane_ & 15, fq = lane_ >> 4, kq = w * 4 + (lane_ >> 4), ch = lane_ & 15;
            const int half = (n & 1) * 128;
#pragma unroll
            for (int i = 0; i < 4; ++i) { const int key = half + 32 * i + kq;
                *(LAS v4u*)(Kl + key * 256 + ((ch ^ (key & 15)) << 4)) = kraw[i];
                *(LAS v4u*)(Vl + key * 256 + ((((ch >> 1) ^ (key & 7)) << 5) | ((ch & 1) << 4))) = vraw[i]; }
            __syncthreads();
            if (s + 1 < nt) { ATT_PREFETCH_BLK(kbase, n + 1); if (s < 0) ATT_PREFETCH_Q(qbase, n + 1); }
            if (s >= 0) {
                const int tq = (128 * n + 16 * w + fr) * dil + p;
                const int hp = 128 - half;
                f32x4 S[10];
#pragma unroll
                for (int kb = 0; kb < 9; ++kb) { const int j = 16 * w + 16 * kb + fr; const int rowk = (j < 128 ? hp : half - 128) + j;
                    const LAS unsigned char* kp = Kl + rowk * 256; f32x4 acc = {0.f, 0.f, 0.f, 0.f};
#pragma unroll
                    for (int ks = 0; ks < 4; ++ks) { const bf16x8 ak = *(const LAS bf16x8*)(kp + (((4 * ks + fq) ^ fr) << 4)); acc = __builtin_amdgcn_mfma_f32_16x16x32_bf16(ak, bq[ks], acc, 0, 0, 0); }
                    S[kb] = acc; }
                if (s + 1 < nt) ATT_PREFETCH_Q(qbase, n + 1);
                float mx = -3.0e38f;
                {
                    const int dj0 = 4 * fq - fr;
                    const float c1 = slope * (float)dil, t0 = c1 * (float)(dj0 - 128); const int jj0 = (n > 0) ? 1024 : 16 * w + 4 * fq;
#pragma unroll
                    for (int kb = 0; kb < 9; ++kb)
#pragma unroll
                        for (int r = 0; r < 4; ++r) { const int dj = dj0 + (16 * kb + r); const bool valid = (unsigned)dj <= 128u && jj0 + (16 * kb + r) >= 128;
                            const float sv = fmaf(c1, (float)(16 * kb + r), fmaf(S[kb][r], 0.08838834764831845f, t0)); S[kb][r] = valid ? sv : -1.0e30f; mx = fmaxf(mx, S[kb][r]); }
                }
                mx = fmaxf(mx, xshf<16>(mx)); mx = half_max(mx);
                float den = 0.f;
#pragma unroll
                for (int kb = 0; kb < 9; ++kb)
#pragma unroll
                    for (int r = 0; r < 4; ++r) { const float pp = __expf(S[kb][r] - mx); S[kb][r] = pp; den += pp; }
                S[9] = (f32x4){0.f, 0.f, 0.f, 0.f};
                den += xshf<16>(den); den = half_sum(den);
                f32x4 O[8];
#pragma unroll
                for (int db = 0; db < 8; ++db) O[db] = (f32x4){0.f, 0.f, 0.f, 0.f};
#pragma unroll
                for (int ps = 0; ps < 5; ++ps) { const int kbA = 2 * ps, kbB = 2 * ps + 1;
                    v4u pw; pw.x = cvt_pk_bf16(S[kbA][0], S[kbA][1]); pw.y = cvt_pk_bf16(S[kbA][2], S[kbA][3]); pw.z = cvt_pk_bf16(S[kbB][0], S[kbB][1]); pw.w = cvt_pk_bf16(S[kbB][2], S[kbB][3]);
                    const bf16x8 pb = __builtin_bit_cast(bf16x8, pw);
                    int jA = 16 * w + 16 * kbA + 4 * fq, jB = jA + 16; jA = jA > 252 ? 252 : jA; jB = jB > 252 ? 252 : jB;
                    const int keyA = (jA < 128 ? hp : half - 128) + jA + (fr >> 2), keyB = (jB < 128 ? hp : half - 128) + jB + (fr >> 2);
                    const LAS unsigned char* vA = Vl + keyA * 256 + ((fr & 3) << 3); const LAS unsigned char* vB = Vl + keyB * 256 + ((fr & 3) << 3);
#pragma unroll
                    for (int db = 0; db < 8; ++db) {
                        const att_v4i16 lo = __builtin_amdgcn_ds_read_tr16_b64_v4i16((LAS att_v4i16*)(vA + ((db ^ (keyA & 7)) << 5)));
                        const att_v4i16 hi = __builtin_amdgcn_ds_read_tr16_b64_v4i16((LAS att_v4i16*)(vB + ((db ^ (keyB & 7)) << 5)));
                        const bf16x8 av = __builtin_shufflevector(lo, hi, 0, 1, 2, 3, 4, 5, 6, 7);
                        O[db] = __builtin_amdgcn_mfma_f32_16x16x32_bf16(av, pb, O[db], 0, 0, 0); } }
                const float inv = 1.0f / den; const size_t row = orow0 + tq;
#pragma unroll
                for (int db = 0; db < 8; ++db) { const f32x4 o = O[db] * inv; v2u w2; w2.x = cvt_pk_bf16(o[0], o[1]); w2.y = cvt_pk_bf16(o[2], o[3]); *(v2u*)(OG + row * AW + h * 128 + 16 * db + 4 * fq) = w2; }
                if (fq == 0) LSE[row * 8 + h] = mx + __logf(den);
            }
            __syncthreads();
        }
    }
}
__device__ __forceinline__ void attn_sample(const Frame& F, CArgs* A, int j, const bf16* QKV, bf16* OG, float* LSE) {
    LAS float* sm = (LAS float*)(F.lds + RING_OFF + ATT_S_OFF) + F.wave * 512;
    LAS float* qs = sm; LAS float* ps = sm + 128; LAS float* os = sm + 192; LAS float* ms = sm + 320;
    const int lane = F.lane, hf = F.wave & 1;
    float kscale = 0.08838834764831845f; asm volatile("" : "+s"(kscale));
    constexpr int NIT = SB * ST * 24;
    for (int it0 = F.bx; it0 < NIT; it0 += 4 * F.G) {
        const int it = it0 + F.G * (F.wave >> 1); const bool valid = it < NIT;
        float mx = 0.f, den = 1.f, o0 = 0.f, o1 = 0.f; size_t obase = 0, lbase = 0;
        if (valid) {
            const int h = it & 7, g = (it >> 3) % 3, t = (it / 24) & 3, b = it / 96;
            const int dil = g == 0 ? 1 : (g == 1 ? 4 : 16), win = 128 * dil;
            const float slope = exp2f(-8.0f * (float)(g * 8 + h + 1) / 24.0f);
            const float* cache = A->in[I_C128 + g] + ((size_t)(j * SB + b) * win) * 2048 + h * 128;
            const float* newkv = A->out + O_KVS0 + (size_t)g * (O_KVS1 - O_KVS0) + ((size_t)(j * SB + b) * ST) * 2048 + h * 128;
            const size_t orow = (size_t)g * MT + MP + b * ST + t; obase = orow * AW + h * 128; lbase = orow * 8 + h;
            const unsigned qw = *(const unsigned*)(QKV + (size_t)(b * ST + t) * NQKV + g * 3072 + h * 128 + 2 * lane);
            const int s = 64 * hf + lane, idx = win + t - s * dil;
            const float* kr = idx < win ? cache + (size_t)idx * 2048 : newkv + (size_t)(idx - win) * 2048;
            f32x2 k128 = (f32x2){0.f, 0.f};
            if (hf) k128 = *(const f32x2*)(cache + (size_t)t * 2048 + 2 * lane);
            *(LAS f32x2*)(qs + 2 * lane) = (f32x2){bf_lo(qw), bf_hi(qw)};
            LDS_WAIT();
            float acc = 0.f;
            f32x4 kk[32];
#pragma unroll
            for (int c = 0; c < 32; ++c) kk[c] = *(const f32x4*)(kr + 4 * c);
#pragma unroll
            for (int c0 = 0; c0 < 32; c0 += 8) { LAS float* qc = qs; asm volatile("" : "+v"(qc) : "v"(acc));
#pragma unroll
                for (int c = c0; c < c0 + 8; ++c) { const f32x4 qq = *(const LAS f32x4*)(qc + 4 * c); acc += (kk[c].x * qq.x + kk[c].y * qq.y) + (kk[c].z * qq.z + kk[c].w * qq.w); } }
            const float sc = acc * kscale - slope * (float)(s * dil);
            float sc128 = -3.0e38f;
            if (hf) { const f32x2 q2 = *(const LAS f32x2*)(qs + 2 * lane); sc128 = wave_sum(k128.x * q2.x + k128.y * q2.y) * kscale - slope * (float)(128 * dil); }
            mx = fmaxf(wave_max(sc), sc128);
            const float p = __expf(sc - mx), p128 = hf ? __expf(sc128 - mx) : 0.f;
            den = wave_sum(p) + p128;
            ps[lane] = p;
            LDS_WAIT();
#pragma nounroll
            for (int e0 = 0; e0 < 64; e0 += 32) {
                f32x2 vv[32];
#pragma unroll
                for (int e = 0; e < 32; ++e) { const int ix = win + t - (64 * hf + e0 + e) * dil;
                    const float* vr = (ix < win ? cache + (size_t)ix * 2048 : newkv + (size_t)(ix - win) * 2048) + 1024; vv[e] = *(const f32x2*)(vr + 2 * lane); }
#pragma unroll
                for (int e = 0; e < 32; ++e) { const float pp = ps[e0 + e]; o0 += pp * vv[e].x; o1 += pp * vv[e].y; }
            }
            if (hf) { const f32x2 v128 = *(const f32x2*)(cache + (size_t)t * 2048 + 1024 + 2 * lane); o0 += p128 * v128.x; o1 += p128 * v128.y;
                *(LAS f32x2*)(os + 2 * lane) = (f32x2){o0, o1}; if (lane == 0) { ms[0] = mx; ms[1] = den; } }
        }
        __syncthreads();
        if (valid && hf == 0) {
            const float mx1 = ms[512], den1 = ms[513]; const f32x2 ob = *(const LAS f32x2*)(os + 512 + 2 * lane);
            const float M = fmaxf(mx, mx1), a0 = __expf(mx - M), a1 = __expf(mx1 - M);
            const float dn = den * a0 + den1 * a1, inv = 1.0f / dn;
            *(unsigned*)(OG + obase + 2 * lane) = cvt_pk_bf16((o0 * a0 + ob.x * a1) * inv, (o1 * a0 + ob.y * a1) * inv);
            if (lane == 0) LSE[lbase] = M + __logf(dn);
        }
        __syncthreads();
    }
}
__device__ __forceinline__ void kv_prompt_out(const Frame& F, CArgs* A, int j, const bf16* QKV) {
#pragma unroll 4
    for (int idx = F.gt; idx < 5376 * 256; idx += F.ngt) {
        const int c = (idx & 127) * 8, kv = (idx >> 7) & 1; int rr = idx >> 8; int g, keep; size_t obase;
        if (rr < 256) { g = 0; keep = 128; obase = O_KVP0; } else if (rr < 1280) { g = 1; keep = 512; rr -= 256; obase = O_KVP1; } else { g = 2; keep = 2048; rr -= 1280; obase = O_KVP2; }
        const int b = rr / keep, r = rr - b * keep;
        const int t = TSEQ - keep + r, dsh = 2 * g, pos = ((t & ((1 << dsh) - 1)) << (12 - dsh)) + (t >> dsh);
        float x[8]; unpack8(*(const v4u*)(QKV + ((size_t)((g * 3 + 1 + kv) * 8 + (c >> 7)) * 2 + b) * (4096 * 128) + (size_t)pos * 128 + (c & 127)), x);
        store8f(A->out + obase + (((size_t)(j * 2 + b) * keep + r) * 2 + kv) * 1024 + c, x);
    }
}
__device__ __forceinline__ void attn_combine(const Frame& F, const bf16* OG, const float* LSE, bf16* O) {
#pragma unroll 4
    for (int idx = F.gt; idx < MT * 128; idx += F.ngt) {
        const int m = idx >> 7, hc = idx & 127, h = hc >> 4;
        const float l0 = LSE[((size_t)0 * MT + m) * 8 + h], l1 = LSE[((size_t)1 * MT + m) * 8 + h], l2 = LSE[((size_t)2 * MT + m) * 8 + h];
        const float mx = fmaxf(fmaxf(l0, l1), l2); float w0 = __expf(l0 - mx), w1 = __expf(l1 - mx), w2 = __expf(l2 - mx); const float inv = 1.0f / (w0 + w1 + w2); w0 *= inv; w1 *= inv; w2 *= inv;
        float a[8], bb[8], cc[8], o[8];
        unpack8(*(const v4u*)(OG + ((size_t)0 * MT + m) * AW + hc * 8), a); unpack8(*(const v4u*)(OG + ((size_t)1 * MT + m) * AW + hc * 8), bb); unpack8(*(const v4u*)(OG + ((size_t)2 * MT + m) * AW + hc * 8), cc);
#pragma unroll
        for (int e = 0; e < 8; ++e) o[e] = w0 * a[e] + w1 * bb[e] + w2 * cc[e];
        *(v4u*)(O + (size_t)m * AW + hc * 8) = pack8(o);
    }
}

#define PH const Frame F = mk_frame((LAS unsigned char*)lds, wv0); CArgs* A = kargs(); unsigned char* const ws = A->ws; LAS unsigned char* const ring = F.lds + RING_OFF; (void)ring; (void)ws;
#define P_X ((float*)(ws + WS_X))
#define P_XS (P_X + (size_t)MP * DM)
#define P_XN ((bf16*)(ws + WS_XN))
#define P_S (ws + WS_S)
#define P_GG ((bf16*)(P_S + S_GG))
#define P_U ((bf16*)(P_S + S_U))
#define P_UC ((bf16*)(P_S + S_UC))
#define P_HG ((bf16*)(P_S + S_HG))
#define P_LA ((bf16*)(P_S + S_LA))
#define P_GI ((bf16*)(P_S + S_GI))
#define P_QKV ((bf16*)(P_S + S_QKV))
#define P_QS (P_QKV + (size_t)MP * NQKV)
#define P_OG ((bf16*)(P_S + S_OG))
#define P_LSE ((float*)(P_S + S_LSE))
#define P_OB ((bf16*)(P_S + S_O))
#define P_UPS ((bf16*)(P_S + S_UPS))
#define P_HB ((bf16*)(P_S + S_HB))
#define P_ACT ((bf16*)(P_S + S_ACT))
#define P_CA ((float*)(ws + WS_SC))
#define P_CB ((float*)(ws + WS_SC + 1 * MiB))
#define P_HIN ((float*)(ws + WS_SC + 2 * MiB))
#define P_SP ((float*)(ws + WS_MISC))
#define P_SSP(k) ((float*)(ws + WS_SSP) + (size_t)(k) * MP * 8)
#define P_SSS(k) ((float*)(ws + WS_SSS) + (size_t)(k) * 32 * 128)
#define P_T ((pg8::PG8_LAS_T)(F.lds + EPI_T_OFF))
__global__ void __launch_bounds__(NWAVES * 64, 2) fwd(Args args_unused) {
    extern __shared__ __attribute__((aligned(16))) unsigned char lds[];
    XcdBarrier bar;
    const int wv0 = __builtin_amdgcn_readfirstlane((int)(threadIdx.x >> 6));
    {
        PH;
        for (int u = F.tid; u < (LDS_BYTES - LDSCTL_OFF) / 4; u += NTHR) ((LAS unsigned*)(F.lds + LDSCTL_OFF))[u] = 0u;
        __syncthreads();
        bar = xcd_barrier_post((unsigned*)((gu32*)(ws + WS_CTL) + CW_BAR), (volatile LAS unsigned*)(F.lds + MISC_OFF) + 8, wv0);
        p0_prologue(F, A, ws);
    }
    xcd_barrier(bar);

#pragma nounroll
    for (int pair = 0; pair < DEPTH / 2; ++pair) {
        {   const int layer = 2 * pair; const int j = layer >> 1; (void)j;
            {   PH;
                const bf16* Wl = (bf16*)(ws + WS_WIN) + (size_t)j * 4096 * DM; const float* b_in = A->in[I_LBIN] + (size_t)j * 4096;
                TWin fn{P_GG, P_U, b_in}; thin_gemm<1>(F, P_XN + (size_t)MP * DM, DM, 0, Wl, 4096, DM, fn, P_SSS(2 * layer));
                pg8::Gemm g{P_XN, Wl, MP, 4096, DM, DM, 0}; pg8::StaticOrder So; So.init(MP, 4096, F.G, F.bx);
                pg8::EpiBf<1> E{P_GG, DM, b_in, P_U, P_SSP(2 * layer)};
                pg8::gemm_phase<pg8::EpiBf<1>, pg8::StaticOrder, PG8_ALIGN, PG8_SP2>(ring, g, So, E, F.wave);
            }
            xcd_barrier(bar);
            {   PH;
                lru_conv_own(F, A, j, P_U, P_UC);
                const bf16* Gl = (bf16*)(ws + WS_GT) + (size_t)j * 4096 * 256; const float* b_a = A->in[I_LBA] + (size_t)j * 2048; const float* b_i = A->in[I_LBI] + (size_t)j * 2048; const float* sp = P_SP + (size_t)j * 2048;
                TGates fn{P_LA, P_GI, P_UC, b_a, b_i, sp}; thin_gemm<1>(F, P_UC + (size_t)MP * DM, DM, 8, Gl, 4096, 256, fn);
                pg8::Gemm g{P_UC, Gl, MP, 4096, 256, DM, 8}; pg8::GatesOrder So; So.init(F.G, F.bx);
                pg8::EpiGates E{P_LA, P_GI, P_UC, b_a, b_i, sp};
                pg8::gemm_phase<pg8::EpiGates, pg8::GatesOrder, PG8_ALIGN, PG8_SP2>(ring, g, So, E, F.wave);
            }
            xcd_barrier(bar);
            {   PH; scan_pass1(F, P_LA, P_GI, P_CA, P_CB); }
            xcd_barrier(bar);
            {   PH; scan_pass2(F, P_CA, P_CB, P_HIN); }
            xcd_barrier(bar);
            {   PH; scan_pass3(F, A, j, P_LA, P_GI, P_HIN, P_GG, P_HG); }
            xcd_barrier(bar);
            {   PH;
                const bf16* Wo = (bf16*)(ws + WS_WOUT) + (size_t)j * DM * DM; const float* b_out = A->in[I_LBOUT] + (size_t)j * DM;
                TResid fn{P_XN + (size_t)MP * DM, b_out, P_SSS(2 * layer + 1)}; thin_gemm<1>(F, P_HG + (size_t)MP * DM, DM, 0, Wo, DM, DM, fn);
                pg8::Gemm g{P_HG, Wo, MP, DM, DM, DM, 0}; pg8::StaticOrder So; So.init(MP, DM, F.G, F.bx);
                pg8::EpiResid E{P_XN, DM, b_out, P_SSP(2 * layer + 1), P_T};
                pg8::gemm_phase<pg8::EpiResid, pg8::StaticOrder, PG8_ALIGN, PG8_SP2>(ring, g, So, E, F.wave);
            }
            xcd_barrier(bar);
        }
        {   const int layer = 2 * pair; const int j = layer >> 1; (void)j;
        {   PH;
            const bf16* Wl = (bf16*)(ws + WS_WUP) + (size_t)layer * FF2 * DM;
            TUp fn{P_UPS}; thin_gemm<3>(F, P_XN + (size_t)MP * DM, DM, 0, Wl, FF2, DM, fn, P_SSS(2 * layer + 1));
            pg8::Gemm g{P_XN, Wl, MP, FF2, DM, DM, 0}; pg8::StaticOrder So; So.init(MP, FF2, F.G, F.bx);
            pg8::EpiUpGlu E{P_ACT, P_HB, A->in[I_FCW] + (size_t)layer * 3 * FF2, A->in[I_FCB] + (size_t)layer * FF2, P_SSP(2 * layer + 1)};
            pg8::gemm_phase<pg8::EpiUpGlu, pg8::StaticOrder, PG8_ALIGN, PG8_SP2>(ring, g, So, E, F.wave);
        }
        xcd_barrier(bar);
        {   PH; ffn_fix(F, A, layer, P_HB, P_UPS, P_ACT); }
        xcd_barrier(bar);
        {   PH;
            const bf16* Wl = (bf16*)(ws + WS_WDN) + (size_t)layer * DM * FF;
            TResid fn{P_XN + (size_t)MP * DM, nullptr, P_SSS(2 * layer + 2)}; thin_gemm<1, 12>(F, P_ACT + (size_t)MP * FF, FF, 0, Wl, DM, FF, fn);
            pg8::Gemm g{P_ACT, Wl, MP, DM, FF, FF, 0}; pg8::StaticOrder So; So.init(MP, DM, F.G, F.bx);
            pg8::EpiResid E{P_XN, DM, nullptr, P_SSP(2 * layer + 2), P_T};
            pg8::gemm_phase<pg8::EpiResid, pg8::StaticOrder, PG8_ALIGN, PG8_SP2>(ring, g, So, E, F.wave);
        }
        xcd_barrier(bar);
        if (layer == DEPTH - 1) { PH; norm_rows_out(F, P_XN, A->in[I_NFIN], A->out + O_YP, A->out + O_YS); }
        }
        {   const int layer = 2 * pair + 1; const int j = layer >> 1; (void)j;
            {   PH;
                const bf16* Wl = (bf16*)(ws + WS_WQKV) + (size_t)j * NQKV * DM;
                {   constexpr int NU = (MP / 256) * (NQKV / 256); const int rounds = (NU + F.G - 1) / F.G; int c0 = NU - (rounds - 1) * F.G; if (c0 >= F.G) c0 = 0;
                    if (F.bx >= c0) { Frame F2 = F; F2.bx = F.bx - c0; F2.G = F.G - c0; TQkv fn{P_QS, A->out + O_KVS0, j}; thin_gemm<3>(F2, P_XN + (size_t)MP * DM, DM, 0, Wl, NQKV, DM, fn, P_SSS(2 * layer)); } }
                pg8::Gemm g{P_XN, Wl, MP, NQKV, DM, DM, 0}; pg8::StaticOrder So; So.init(MP, NQKV, F.G, F.bx);
                pg8::EpiQkv E{P_QKV, P_SSP(2 * layer)};
                pg8::gemm_phase<pg8::EpiQkv, pg8::StaticOrder, PG8_ALIGN, PG8_SP2>(ring, g, So, E, F.wave);
            }
            xcd_barrier(bar);
            {   PH; attn_sample(F, A, j, P_QS, P_OG, P_LSE); __syncthreads(); attn_prompt(F, P_QKV, P_OG, P_LSE); kv_prompt_out(F, A, j, P_QKV); }
            xcd_barrier(bar);
            {   PH; attn_combine(F, P_OG, P_LSE, P_OB); }
            xcd_barrier(bar);
            {   PH;
                const bf16* Wo = (bf16*)(ws + WS_WO) + (size_t)j * DM * AW;
                TResid fn{P_XN + (size_t)MP * DM, nullptr, P_SSS(2 * layer + 1)}; thin_gemm<1>(F, P_OB + (size_t)MP * AW, AW, 0, Wo, DM, AW, fn);
                pg8::Gemm g{P_OB, Wo, MP, DM, AW, AW, 0}; pg8::StaticOrder So; So.init(MP, DM, F.G, F.bx);
                pg8::EpiResid E{P_XN, DM, nullptr, P_SSP(2 * layer + 1), P_T};
                pg8::gemm_phase<pg8::EpiResid, pg8::StaticOrder, PG8_ALIGN, PG8_SP2>(ring, g, So, E, F.wave);
            }
            xcd_barrier(bar);
        }
        {   const int layer = 2 * pair + 1; const int j = layer >> 1; (void)j;
        {   PH;
            const bf16* Wl = (bf16*)(ws + WS_WUP) + (size_t)layer * FF2 * DM;
            TUp fn{P_UPS}; thin_gemm<3>(F, P_XN + (size_t)MP * DM, DM, 0, Wl, FF2, DM, fn, P_SSS(2 * layer + 1));
            pg8::Gemm g{P_XN, Wl, MP, FF2, DM, DM, 0}; pg8::StaticOrder So; So.init(MP, FF2, F.G, F.bx);
            pg8::EpiUpGlu E{P_ACT, P_HB, A->in[I_FCW] + (size_t)layer * 3 * FF2, A->in[I_FCB] + (size_t)layer * FF2, P_SSP(2 * layer + 1)};
            pg8::gemm_phase<pg8::EpiUpGlu, pg8::StaticOrder, PG8_ALIGN, PG8_SP2>(ring, g, So, E, F.wave);
        }
        xcd_barrier(bar);
        {   PH; ffn_fix(F, A, layer, P_HB, P_UPS, P_ACT); }
        xcd_barrier(bar);
        {   PH;
            const bf16* Wl = (bf16*)(ws + WS_WDN) + (size_t)layer * DM * FF;
            TResid fn{P_XN + (size_t)MP * DM, nullptr, P_SSS(2 * layer + 2)}; thin_gemm<1, 12>(F, P_ACT + (size_t)MP * FF, FF, 0, Wl, DM, FF, fn);
            pg8::Gemm g{P_ACT, Wl, MP, DM, FF, FF, 0}; pg8::StaticOrder So; So.init(MP, DM, F.G, F.bx);
            pg8::EpiResid E{P_XN, DM, nullptr, P_SSP(2 * layer + 2), P_T};
            pg8::gemm_phase<pg8::EpiResid, pg8::StaticOrder, PG8_ALIGN, PG8_SP2>(ring, g, So, E, F.wave);
        }
        xcd_barrier(bar);
        if (layer == DEPTH - 1) { PH; norm_rows_out(F, P_XN, A->in[I_NFIN], A->out + O_YP, A->out + O_YS); }
        }
    }
}

extern "C" void kernel_launch(void* const* d_in, const int* in_sizes, int n_in, void* d_out, int out_size, void* d_ws, size_t ws_size, hipStream_t stream) {
    static int grid = 0;
    if (grid == 0) {
        if (n_in != N_IN || (size_t)out_size != O_END || ws_size < WS_END) { fprintf(stderr, "kernel_launch: unexpected shapes: n_in %d out %d ws %zu (need %zu)\n", n_in, out_size, ws_size, (size_t)WS_END); grid = -1; return; }
        int dev = 0, cus = 0, per_cu = 0;
        if (hipGetDevice(&dev) != hipSuccess || hipDeviceGetAttribute(&cus, hipDeviceAttributeMultiprocessorCount, dev) != hipSuccess) { grid = -1; return; }
        if (hipFuncSetAttribute((const void*)fwd, hipFuncAttributeMaxDynamicSharedMemorySize, LDS_BYTES) != hipSuccess) { fprintf(stderr, "kernel_launch: hipFuncSetAttribute failed\n"); grid = -1; return; }
        if (hipOccupancyMaxActiveBlocksPerMultiprocessor(&per_cu, (const void*)fwd, NWAVES * 64, LDS_BYTES) != hipSuccess || per_cu < 1) { fprintf(stderr, "kernel_launch: occupancy query reports %d blocks per CU\n", per_cu); }
        (void)hipGetLastError();
        grid = cus;
    }
    if (grid < 0) return;
    if (hipMemsetAsync((char*)d_ws + WS_CTL, 0, CTL_ZERO_BYTES, stream) != hipSuccess) return;
    Args a{};
    for (int i = 0; i < N_IN; ++i) a.in[i] = (const float*)d_in[i];
    a.out = (float*)d_out; a.ws = (unsigned char*)d_ws;
    hipLaunchKernelGGL(fwd, dim3(grid), dim3(NWAVES * 64), LDS_BYTES, stream, a);
}
```

```cpp
#include <hip/hip_runtime.h>
#include <cstdio>
#include <cstdint>
#include <cmath>
namespace pg8 {
#define PG8_LAS __attribute__((address_space(3)))
typedef unsigned short bf16_t;
typedef PG8_LAS float* PG8_LAS_T;
typedef short bf16x8 __attribute__((ext_vector_type(8)));
typedef float f32x4 __attribute__((ext_vector_type(4)));
typedef unsigned u32x4 __attribute__((ext_vector_type(4)));
constexpr int BM = 256, BK = 64, HALF = 128, HTB = HALF * BK * 2  , STAGE_BYTES = 8 * HTB, NXCD = 8, WGM = 8;

__host__ __device__ __forceinline__ int lds_byte(int r, int c) { const int st = (r >> 4) * 2 + (c >> 5), rr = r & 15, cc = c & 31, ob = rr * 64 + cc * 2; return st * 1024 + (ob ^ (((ob >> 9) & 1) << 5)); }
__host__ __device__ __forceinline__ void stage_rc(int b, int& R, int& C) { const int st = b / 1024, sb = b % 1024, swz = sb ^ (((sb >> 9) & 1) << 5); R = (st >> 1) * 16 + swz / 64; C = (st & 1) * 32 + (swz % 64) / 2; }
__host__ __device__ __forceinline__ int perm32(int rho) { const int n = rho >> 4, i = rho & 15; return 8 * (i >> 2) + 4 * n + (i & 3); }

struct Unit { int pm, pn; };
struct Gemm { const bf16_t* A; const bf16_t* Bt; int M, N, K, lda, amod; };

struct GatesOrder {
    int G, c;
    __host__ __device__ void init(int G_, int c_) { G = G_; c = c_; }
    __host__ __device__ bool next(int i, Unit& u) const { const int P = (i >> 1) * G + c; if (P >= 256) return false; u.pm = P >> 3; u.pn = (P & 7) + 8 * (i & 1); return true; }
    __device__ __forceinline__ void a_ready(const Unit&) const {}
    __device__ __forceinline__ void done(const Unit&) const {}
};
struct StaticOrder {
    int nM, nN, nwg, G, c;
    __host__ __device__ void init(int M, int N, int G_, int c_) { nM = M / BM; nN = N / BM; nwg = nM * nN; G = G_; c = c_; }
    __host__ __device__ bool next(int i, Unit& u) const {
        const long L = (long)i * G + c; if (L >= nwg) return false;
        int wgid = (int)L; { const int q = nwg / NXCD, r = nwg % NXCD, xcd = wgid % NXCD, off = wgid / NXCD; wgid = (xcd < r ? xcd * (q + 1) : r * (q + 1) + (xcd - r) * q) + off; }
        const int nig = WGM * nN, gid = wgid / nig, fm = gid * WGM, gsz = (nM - fm) < WGM ? (nM - fm) : WGM;
        u.pm = fm + ((wgid % nig) % gsz); u.pn = (wgid % nig) / gsz; return true;
    }
    __device__ __forceinline__ void a_ready(const Unit&) const {}
    __device__ __forceinline__ void done(const Unit&) const {}
};


__device__ __forceinline__ unsigned cvt_pk_bf16(float lo, float hi) { unsigned r; asm volatile("v_cvt_pk_bf16_f32 %0, %1, %2" : "=v"(r) : "v"(lo), "v"(hi)); return r; }
__device__ __forceinline__ float gelu_tanh(float x) { const float t = x * (1.5957691216f + 0.0713548163f * x * x); return x * __builtin_amdgcn_rcpf(1.0f + __builtin_amdgcn_exp2f(-1.4426950409f * t)); }
__device__ __forceinline__ f32x4 gelu_tanh4(f32x4 x) { const f32x4 t = x * x; const f32x4 u = t * (-0.10294325f) + (-2.3022082f); const f32x4 z = x * u;
    f32x4 e; e[0] = __builtin_amdgcn_exp2f(z[0]); e[1] = __builtin_amdgcn_exp2f(z[1]); e[2] = __builtin_amdgcn_exp2f(z[2]); e[3] = __builtin_amdgcn_exp2f(z[3]);
    const f32x4 d = e + 1.0f; f32x4 r; r[0] = __builtin_amdgcn_rcpf(d[0]); r[1] = __builtin_amdgcn_rcpf(d[1]); r[2] = __builtin_amdgcn_rcpf(d[2]); r[3] = __builtin_amdgcn_rcpf(d[3]); return x * r; }
typedef float f32x2g __attribute__((ext_vector_type(2)));
__device__ __forceinline__ f32x2g gelu_tanh2(f32x2g x) { const f32x2g t = x * x; const f32x2g u = t * (-0.10294325f) + (-2.3022082f); const f32x2g z = x * u;
    f32x2g e; e[0] = __builtin_amdgcn_exp2f(z[0]); e[1] = __builtin_amdgcn_exp2f(z[1]); const f32x2g d = e + 1.0f; f32x2g r; r[0] = __builtin_amdgcn_rcpf(d[0]); r[1] = __builtin_amdgcn_rcpf(d[1]); return x * r; }
__device__ __forceinline__ float sigmoid_f(float x) { return __builtin_amdgcn_rcpf(1.0f + __builtin_amdgcn_exp2f(-1.4426950409f * x)); }
__device__ __forceinline__ float bf_lo(unsigned w) { return __uint_as_float(w << 16); }
__device__ __forceinline__ float bf_hi(unsigned w) { return __uint_as_float(w & 0xffff0000u); }
template <int O> __device__ __forceinline__ float xshf(float v) { return __int_as_float(__builtin_amdgcn_ds_swizzle(__float_as_int(v), (O << 10) | 0x1f)); }
__device__ __forceinline__ float half_sum(float v) { const auto rr = __builtin_amdgcn_permlane32_swap(__float_as_uint(v), __float_as_uint(v), false, false); return __uint_as_float(rr[0]) + __uint_as_float(rr[1]); }
__device__ __forceinline__ float half_max(float v) { const auto rr = __builtin_amdgcn_permlane32_swap(__float_as_uint(v), __float_as_uint(v), false, false); return fmaxf(__uint_as_float(rr[0]), __uint_as_float(rr[1])); }
__device__ __forceinline__ float rstd_ss(float ss) { return __builtin_amdgcn_rsqf(ss * (1.0f / 2048.0f) + 1e-6f); }
__device__ __forceinline__ float rstd_row8(const float* p) { const f32x4 a = *(const f32x4*)p, b = *(const f32x4*)(p + 4); return rstd_ss(((a[0] + a[1]) + (a[2] + a[3])) + ((b[0] + b[1]) + (b[2] + b[3]))); }

struct PreRow { f32x4 a; };
__device__ __forceinline__ void pre_row_load(PreRow& p, const float* SSP, int pm, int tid) { p.a = *(const f32x4*)(SSP + (size_t)(pm * BM + (tid & 255)) * 8 + 4 * (tid >> 8)); }
__device__ __forceinline__ void pre_row_publish(PG8_LAS float* L, const PreRow& p, int tid) {
    const int t = tid & 255, ai = t >> 7, wr = (t >> 6) & 1, m = (t >> 4) & 3, fr = t & 15;
    L[(tid >> 8) * 256 + (ai * 2 + wr) * 64 + 4 * fr + m] = (p.a[0] + p.a[1]) + (p.a[2] + p.a[3]); }
__device__ __forceinline__ f32x4 pre_row_read(const PG8_LAS float* L, int ai, int wr, int fr) {
    const f32x4 s0 = *(const PG8_LAS f32x4*)(L + (ai * 2 + wr) * 64 + 4 * fr), s1 = *(const PG8_LAS f32x4*)(L + 256 + (ai * 2 + wr) * 64 + 4 * fr);
    return (f32x4){rstd_ss(s0[0] + s1[0]), rstd_ss(s0[1] + s1[1]), rstd_ss(s0[2] + s1[2]), rstd_ss(s0[3] + s1[3])}; }
template <int MODE> struct EpiBf {
    static constexpr bool HAS_PRE = true;
    static constexpr bool PERM = true, PERMA = false, AFTER_DRAIN = false;
    struct Pre { PreRow r; float c; };
    __device__ __forceinline__ Pre prefetch(const Unit& u, int tid) const { Pre p; pre_row_load(p.r, SSP, u.pm, tid); p.c = (MODE == 1 && tid < 256) ? bias[u.pn * BM + tid] : 0.f; return p; }
    bf16_t* O; int ldc; const float* bias; bf16_t* O2; const float* SSP;
    __device__ __forceinline__ void operator()(const f32x4 (&acc)[2][2][4][2], const Unit& u, int wr, int wc, int fr, int fq, const Pre& pre, PG8_LAS unsigned char* lds, int tid) const {
        const int row0 = u.pm * BM + wr * 64 + fr; int colt = u.pn * BM; bf16_t* base = O; bool act = false;
        if (MODE == 1) { if (u.pn >= 8) { base = O2; colt -= 2048; } else act = true; }
        const int col0 = colt + wc * 32 + 8 * fq;
        PG8_LAS float* L = (PG8_LAS float*)(lds + 131072);
        pre_row_publish(L, pre.r, tid);
        if (MODE == 1 && tid < 256) L[512 + tid] = pre.c;
        asm volatile("s_waitcnt lgkmcnt(0)" ::: "memory"); __builtin_amdgcn_s_barrier(); asm volatile("" ::: "memory");
        f32x4 bv[2][2]; f32x4 rsv[2];
#pragma unroll
        for (int bj = 0; bj < 2; ++bj)
#pragma unroll
            for (int n = 0; n < 2; ++n) bv[bj][n] = (MODE == 1) ? *(const PG8_LAS f32x4*)(L + 512 + bj * HALF + wc * 32 + 8 * fq + 4 * n) : (f32x4){0.f, 0.f, 0.f, 0.f};
#pragma unroll
        for (int ai = 0; ai < 2; ++ai) rsv[ai] = pre_row_read(L, ai, wr, fr);
#pragma unroll
        for (int ai = 0; ai < 2; ++ai)
#pragma unroll
            for (int m = 0; m < 4; ++m) { bf16_t* rowp = base + (size_t)(row0 + ai * HALF + m * 16) * ldc + col0; const float rs = rsv[ai][m];
#pragma unroll
                for (int bj = 0; bj < 2; ++bj) { f32x4 v0 = acc[ai][bj][m][0] * rs + bv[bj][0], v1 = acc[ai][bj][m][1] * rs + bv[bj][1];
                    if (MODE == 1) { if (act) {
#pragma unroll
                        for (int e = 0; e < 1; ++e) { v0 = gelu_tanh4(v0); v1 = gelu_tanh4(v1); } } }
                    u32x4 w; w.x = cvt_pk_bf16(v0[0], v0[1]); w.y = cvt_pk_bf16(v0[2], v0[3]); w.z = cvt_pk_bf16(v1[0], v1[1]); w.w = cvt_pk_bf16(v1[2], v1[3]);
                    *(u32x4*)(rowp + bj * HALF) = w; } }
    }
};
struct EpiQkv {
    static constexpr bool HAS_PRE = true;
    static constexpr bool PERM = true, PERMA = false, AFTER_DRAIN = false;
    bf16_t* QP; const float* SSP;
    typedef PreRow Pre;
    __device__ __forceinline__ Pre prefetch(const Unit& u, int tid) const { Pre p; pre_row_load(p, SSP, u.pm, tid); return p; }
    __device__ __forceinline__ void operator()(const f32x4 (&acc)[2][2][4][2], const Unit& u, int wr, int wc, int fr, int fq, const Pre& pre, PG8_LAS unsigned char* lds, int tid) const {
        PG8_LAS float* L = (PG8_LAS float*)(lds + 131072);
        pre_row_publish(L, pre, tid);
        asm volatile("s_waitcnt lgkmcnt(0)" ::: "memory"); __builtin_amdgcn_s_barrier(); asm volatile("" ::: "memory");
        f32x4 rsv[2];
#pragma unroll
        for (int ai = 0; ai < 2; ++ai) rsv[ai] = pre_row_read(L, ai, wr, fr);
        const int g = u.pn / 12, part = (u.pn - g * 12) >> 2, h0 = (u.pn & 3) * 2;
        const int dsh = 2 * g, lsh = 12 - dsh;
        const int row0 = u.pm * BM + wr * 64 + fr, b = row0 >> 12;
        bf16_t* base = QP + ((size_t)((g * 3 + part) * 8 + h0) * 2 + b) * (4096 * 128) + wc * 32 + 8 * fq;
#pragma unroll
        for (int ai = 0; ai < 2; ++ai)
#pragma unroll
            for (int m = 0; m < 4; ++m) { const int row = row0 + ai * HALF + m * 16, t = row & 4095; const int pos = ((t & ((1 << dsh) - 1)) << lsh) + (t >> dsh);
                const float rs = rsv[ai][m];
#pragma unroll
                for (int bj = 0; bj < 2; ++bj) { const f32x4 v0 = acc[ai][bj][m][0] * rs, v1 = acc[ai][bj][m][1] * rs;
                    u32x4 w; w.x = cvt_pk_bf16(v0[0], v0[1]); w.y = cvt_pk_bf16(v0[2], v0[3]); w.z = cvt_pk_bf16(v1[0], v1[1]); w.w = cvt_pk_bf16(v1[2], v1[3]);
                    *(u32x4*)(base + (size_t)bj * (2 * 4096 * 128) + (size_t)pos * 128) = w; } }
    }
};
struct EpiGates {
    static constexpr bool HAS_PRE = false;
    static constexpr bool PERM = true, PERMA = false, AFTER_DRAIN = false;
    bf16_t* OMA; bf16_t* GI; const bf16_t* UC; const float* b_a; const float* b_i; const float* sp;
    __device__ __forceinline__ void operator()(const f32x4 (&acc)[2][2][4][2], const Unit& u, int wr, int wc, int fr, int fq) const {
        const int row0 = u.pm * BM + wr * 64 + fr; const bool isA = u.pn < 8; const int col0 = (u.pn & 7) * BM + wc * 32 + 8 * fq;
        const float* bsrc = isA ? b_a : b_i;
        f32x4 bv[2][2], sv[2][2];
#pragma unroll
        for (int bj = 0; bj < 2; ++bj)
#pragma unroll
            for (int n = 0; n < 2; ++n) { bv[bj][n] = *(const f32x4*)(bsrc + col0 + bj * HALF + 4 * n); sv[bj][n] = *(const f32x4*)(sp + col0 + bj * HALF + 4 * n) * (-8.0f * 1.4426950409f); }
#pragma unroll
        for (int ai = 0; ai < 2; ++ai)
#pragma unroll
            for (int m = 0; m < 4; ++m) { const size_t off = (size_t)(row0 + ai * HALF + m * 16) * 2048 + col0;
#pragma unroll
                for (int bj = 0; bj < 2; ++bj) { const f32x4 v0 = acc[ai][bj][m][0] + bv[bj][0], v1 = acc[ai][bj][m][1] + bv[bj][1]; float o[8];
                    if (isA) {
#pragma unroll
                        for (int e = 0; e < 4; ++e) { o[e] = 1.0f - __builtin_amdgcn_exp2f(sigmoid_f(v0[e]) * sv[bj][0][e]); o[4 + e] = 1.0f - __builtin_amdgcn_exp2f(sigmoid_f(v1[e]) * sv[bj][1][e]); }
                    } else {
                        const u32x4 uw = *(const u32x4*)(UC + off + bj * HALF);
                        o[0] = sigmoid_f(v0[0]) * bf_lo(uw.x); o[1] = sigmoid_f(v0[1]) * bf_hi(uw.x); o[2] = sigmoid_f(v0[2]) * bf_lo(uw.y); o[3] = sigmoid_f(v0[3]) * bf_hi(uw.y);
                        o[4] = sigmoid_f(v1[0]) * bf_lo(uw.z); o[5] = sigmoid_f(v1[1]) * bf_hi(uw.z); o[6] = sigmoid_f(v1[2]) * bf_lo(uw.w); o[7] = sigmoid_f(v1[3]) * bf_hi(uw.w);
                    }
                    u32x4 w; w.x = cvt_pk_bf16(o[0], o[1]); w.y = cvt_pk_bf16(o[2], o[3]); w.z = cvt_pk_bf16(o[4], o[5]); w.w = cvt_pk_bf16(o[6], o[7]);
                    if (isA) *(u32x4*)(OMA + off + bj * HALF) = w; else *(u32x4*)(GI + off + bj * HALF) = w; } }
    }
};
struct EpiResid {
    static constexpr bool HAS_PRE = true;
    struct Pre { float c; };
    __device__ __forceinline__ Pre prefetch(const Unit& u, int tid) const { Pre p; p.c = (bias && tid < 256) ? bias[u.pn * BM + tid] : 0.f; return p; }
    static constexpr bool PERM = true, PERMA = false, AFTER_DRAIN = false;
    bf16_t* XB; int ldc; const float* bias; float* SSP; PG8_LAS float* T;
    __device__ __forceinline__ void operator()(const f32x4 (&acc)[2][2][4][2], const Unit& u, int wr, int wc, int fr, int fq, const Pre& pre, PG8_LAS unsigned char* lds, int tid) const {
        const int row0 = u.pm * BM + wr * 64 + fr, col0 = u.pn * BM + wc * 32 + 8 * fq;
        PG8_LAS float* LB = (PG8_LAS float*)(lds + 131072 + 4096);
        if (tid < 256) LB[tid] = pre.c;
        asm volatile("s_waitcnt lgkmcnt(0)" ::: "memory"); __builtin_amdgcn_s_barrier(); asm volatile("" ::: "memory");
        const PG8_LAS float* lb = LB + wc * 32 + 8 * fq;
        u32x4 xin[2][4][2];
#pragma unroll
        for (int ai = 0; ai < 2; ++ai)
#pragma unroll
            for (int m = 0; m < 4; ++m)
#pragma unroll
                for (int bj = 0; bj < 2; ++bj) xin[ai][m][bj] = *(const u32x4*)(XB + (size_t)(row0 + ai * HALF + m * 16) * ldc + col0 + bj * HALF);
        __builtin_amdgcn_sched_barrier(0);
#pragma unroll
        for (int ai = 0; ai < 2; ++ai)
#pragma unroll
            for (int m = 0; m < 4; ++m) { const int row = row0 + ai * HALF + m * 16; const size_t off = (size_t)row * ldc + col0; float ss = 0.f;
#pragma unroll
                for (int bj = 0; bj < 2; ++bj) { const u32x4 xw = xin[ai][m][bj];
                    const f32x4 b0 = *(const PG8_LAS f32x4*)(lb + bj * HALF), b1 = *(const PG8_LAS f32x4*)(lb + bj * HALF + 4);
                    const f32x4 v0 = (f32x4){bf_lo(xw.x), bf_hi(xw.x), bf_lo(xw.y), bf_hi(xw.y)} + acc[ai][bj][m][0] + b0, v1 = (f32x4){bf_lo(xw.z), bf_hi(xw.z), bf_lo(xw.w), bf_hi(xw.w)} + acc[ai][bj][m][1] + b1;
                    u32x4 w; w.x = cvt_pk_bf16(v0[0], v0[1]); w.y = cvt_pk_bf16(v0[2], v0[3]); w.z = cvt_pk_bf16(v1[0], v1[1]); w.w = cvt_pk_bf16(v1[2], v1[3]);
                    *(u32x4*)(XB + off + bj * HALF) = w;
                    const float r0 = bf_lo(w.x), r1 = bf_hi(w.x), r2 = bf_lo(w.y), r3 = bf_hi(w.y), r4 = bf_lo(w.z), r5 = bf_hi(w.z), r6 = bf_lo(w.w), r7 = bf_hi(w.w);
                    ss += ((r0 * r0 + r1 * r1) + (r2 * r2 + r3 * r3)) + ((r4 * r4 + r5 * r5) + (r6 * r6 + r7 * r7)); }
                ss += xshf<16>(ss); ss = half_sum(ss);
                if (fq == 0) T[(ai * HALF + wr * 64 + m * 16 + fr) * 4 + wc] = ss; }
        asm volatile("s_waitcnt lgkmcnt(0)" ::: "memory"); __builtin_amdgcn_s_barrier(); asm volatile("" ::: "memory");
        if (tid < 256) { const f32x4 t = *(const PG8_LAS f32x4*)(T + tid * 4); SSP[(size_t)(u.pm * BM + tid) * 8 + u.pn] = (t[0] + t[1]) + (t[2] + t[3]); }
    }
};

__device__ __forceinline__ float dpp_shr1(float v) { return __builtin_bit_cast(float, __builtin_amdgcn_update_dpp(0, __builtin_bit_cast(int, v), 0x111, 0xf, 0xf, true)); }
struct EpiUpGlu {
    static constexpr bool PERM = true, PERMA = true, AFTER_DRAIN = false, HAS_PRE = true;
    bf16_t* ACT; bf16_t* HB; const float* cw; const float* cb; const float* SSP;
    struct Pre { f32x4 a, b; };
    __device__ __forceinline__ Pre prefetch(const Unit& u, int tid) const {
        Pre p;
        if (tid < 256) { const float* sp = SSP + (size_t)(u.pm * BM + tid) * 8; p.a = *(const f32x4*)sp; p.b = *(const f32x4*)(sp + 4); }
        else { const int i = tid - 256, arr = i >> 5, c4 = (i & 31) * 4; const int k = arr < 3 ? arr : arr - 3;
            const size_t off = (arr < 6 ? (size_t)k * 12288 : (size_t)0) + ((arr >= 3 && arr != 6) ? 6144 : 0) + (size_t)u.pn * 128 + c4;
            const float* base = arr < 6 ? cw : cb; p.a = *(const f32x4*)(base + off); p.b = p.a; }
        return p;
    }
    __device__ __forceinline__ void operator()(const f32x4 (&acc)[2][2][4][2], const Unit& u, int wr, int wc, int fr, int fq, const Pre& pre, PG8_LAS unsigned char* lds, int tid) const {
        const int gcol = u.pn * 128 + wc * 32 + 8 * fq;
        PG8_LAS float* L = (PG8_LAS float*)(lds + 131072);
        if (tid < 256) L[tid] = rstd_ss(((pre.a[0] + pre.a[1]) + (pre.a[2] + pre.a[3])) + ((pre.b[0] + pre.b[1]) + (pre.b[2] + pre.b[3])));
        else *(PG8_LAS f32x4*)(L + 256 + (tid - 256) * 4) = pre.a;
        asm volatile("s_waitcnt lgkmcnt(0)" ::: "memory"); __builtin_amdgcn_s_barrier(); asm volatile("" ::: "memory");
        float rs[2][4];
#pragma unroll
        for (int ai = 0; ai < 2; ++ai) { const f32x4 r = *(const PG8_LAS f32x4*)(L + (ai * 2 + wr) * 64 + 4 * fr);
#pragma unroll
            for (int m = 0; m < 4; ++m) rs[ai][m] = r[m]; }
        const PG8_LAS float* LW = L + 256 + wc * 32 + 8 * fq;
        if (fr == 0 || fr == 15) { const bool hi = fr == 15;
            typedef unsigned u32x2h __attribute__((ext_vector_type(2)));
#pragma unroll
            for (int ai = 0; ai < 2; ++ai) { const int slab = u.pm * 4 + ai * 2 + wr;
#pragma unroll
                for (int r = 0; r < 2; ++r) { const float rsel = hi ? rs[ai][2 + r] : rs[ai][r]; bf16_t* hp = HB + ((size_t)slab * 4 + (hi ? 2 + r : r)) * 12288 + gcol;
#pragma unroll
                    for (int n = 0; n < 2; ++n) { const f32x4 ga = acc[ai][0][r][n], gb = acc[ai][0][2 + r][n], va = acc[ai][1][r][n], vb = acc[ai][1][2 + r][n];
                        f32x4 gsel, vsel;
#pragma unroll
                        for (int q = 0; q < 4; ++q) { gsel[q] = (hi ? gb[q] : ga[q]) * rsel; vsel[q] = (hi ? vb[q] : va[q]) * rsel; }
                        u32x2h hg, hv; hg.x = cvt_pk_bf16(gsel[0], gsel[1]); hg.y = cvt_pk_bf16(gsel[2], gsel[3]); hv.x = cvt_pk_bf16(vsel[0], vsel[1]); hv.y = cvt_pk_bf16(vsel[2], vsel[3]);
                        *(u32x2h*)(hp + 4 * n) = hg; *(u32x2h*)(hp + 6144 + 4 * n) = hv; } } } }
        typedef unsigned u32x2 __attribute__((ext_vector_type(2)));
        u32x2 pk[2][4];
#pragma unroll
        for (int n = 0; n < 2; ++n) {
            f32x4 wg[3], wv[3];
#pragma unroll
            for (int k = 0; k < 3; ++k) { wg[k] = *(const PG8_LAS f32x4*)(LW + k * 128 + 4 * n); wv[k] = *(const PG8_LAS f32x4*)(LW + (3 + k) * 128 + 4 * n); }
            const f32x4 bg = *(const PG8_LAS f32x4*)(LW + 6 * 128 + 4 * n), bv = *(const PG8_LAS f32x4*)(LW + 7 * 128 + 4 * n);
#pragma unroll
            for (int ai = 0; ai < 2; ++ai) {
                const int slab = u.pm * 4 + ai * 2 + wr; const int row0 = slab * 64 + 4 * fr;
                f32x4 g1, g2, v1, v2;
                const f32x4 sg2 = acc[ai][0][2][n] * rs[ai][2], sg3 = acc[ai][0][3][n] * rs[ai][3], sv2 = acc[ai][1][2][n] * rs[ai][2], sv3 = acc[ai][1][3][n] * rs[ai][3];
#pragma unroll
                for (int e = 0; e < 4; ++e) { g1[e] = dpp_shr1(sg3[e]); g2[e] = dpp_shr1(sg2[e]); v1[e] = dpp_shr1(sv3[e]); v2[e] = dpp_shr1(sv2[e]); }
#pragma unroll
                for (int m = 0; m < 4; ++m) { const f32x4 gc = m == 2 ? sg2 : (m == 3 ? sg3 : acc[ai][0][m][n] * rs[ai][m]), vc = m == 2 ? sv2 : (m == 3 ? sv3 : acc[ai][1][m][n] * rs[ai][m]);
                    const f32x4 cg = bg + wg[0] * g2 + wg[1] * g1 + wg[2] * gc, cv = bv + wv[0] * v2 + wv[1] * v1 + wv[2] * vc;
                    const f32x4 gl = gelu_tanh4(cg) * cv; u32x2 o; o.x = cvt_pk_bf16(gl[0], gl[1]); o.y = cvt_pk_bf16(gl[2], gl[3]);
                    if (n == 0) pk[ai][m] = o;
                    else if (!(fr == 0 && m < 2)) { u32x4 w; w.x = pk[ai][m].x; w.y = pk[ai][m].y; w.z = o.x; w.w = o.y; *(u32x4*)(ACT + (size_t)(row0 + m) * 6144 + gcol) = w; }
                    g2 = g1; g1 = gc; v2 = v1; v1 = vc; }
            }
        }
    }
};

struct EpiNull {
    static constexpr bool HAS_PRE = false;
    static constexpr bool PERM = true, PERMA = true, AFTER_DRAIN = false;
    float* sink;
    __device__ __forceinline__ void operator()(const f32x4 (&acc)[2][2][4][2], const Unit& u, int wr, int wc, int fr, int fq) const {
        float s = 0.f;
#pragma unroll
        for (int ai = 0; ai < 2; ++ai)
#pragma unroll
            for (int bj = 0; bj < 2; ++bj)
#pragma unroll
                for (int m = 0; m < 4; ++m)
#pragma unroll
                    for (int n = 0; n < 2; ++n) s += acc[ai][bj][m][n][0] + acc[ai][bj][m][n][1] + acc[ai][bj][m][n][2] + acc[ai][bj][m][n][3];
        if (s == 12345.678f) sink[u.pm] = s;
    }
};

struct NoPreT {};
template <class Epi, bool H> struct PreOf { typedef NoPreT type; };
template <class Epi> struct PreOf<Epi, true> { typedef typename Epi::Pre type; };
template <class Epi, class Sched, bool ALIGN_EPI = false, bool SP2 = false>
__device__ __forceinline__ void gemm_phase(PG8_LAS unsigned char* lds, const Gemm g, const Sched& S, const Epi& E, const int wv) {
    int lane; asm volatile("v_mbcnt_lo_u32_b32 %0, -1, 0\n\tv_mbcnt_hi_u32_b32 %0, -1, %0" : "=v"(lane)); const int wid = wv, tid = wv * 64 + lane, wr = wid >> 2, wc = wid & 3, fr = lane & 15, fq = lane >> 4;
    int K_ = g.K; asm volatile("" : "+s"(K_)); const int K = K_, nt = K / BK;
    unsigned voffA[2], voffB[2];
#pragma unroll
    for (int i = 0; i < 2; ++i) { int R, C; stage_rc(tid * 16 + i * 8192, R, C); const int Rb = Epi::PERM ? ((R & ~31) + perm32(R & 31)) : R;
        const int Ra = Epi::PERMA ? ((R & ~63) + 4 * (R & 15) + ((R >> 4) & 3)) : R;
        voffA[i] = (unsigned)(Ra * g.lda + C) * 2u; voffB[i] = (unsigned)(Rb * K + C) * 2u; }
    const size_t kstep = (size_t)(BK * 2);
    const size_t hstepB = (size_t)HALF * K * 2, hstepA = (size_t)HALF * g.lda * 2;
    const size_t tstepA = 2 * hstepA, tstepB = 2 * hstepB;
    const unsigned ldsw = (unsigned)wid * 1024u;
    const int aoff = lds_byte(wr * 64 + fr, fq * 8), boff = lds_byte(wc * 32 + fr, fq * 8);
#define PG8_SA(b, h) (((b) * 2 + (h)) * HTB)
#define PG8_SB(b, h) ((4 + (b) * 2 + (h)) * HTB)
#define PG8_STAGE(bufoff, gbase, voff) do { _Pragma("unroll") for (int _i = 0; _i < 2; ++_i) \
        __builtin_amdgcn_global_load_lds((const unsigned*)((const char*)(gbase) + (voff)[_i]), (PG8_LAS unsigned*)(lds + (bufoff) + ldsw + _i * 8192), 16, 0, 0); } while (0)
#define PG8_LDA(dst, b, h) do { _Pragma("unroll") for (int m = 0; m < 4; ++m) _Pragma("unroll") for (int k = 0; k < 2; ++k) dst[m][k] = *(const PG8_LAS bf16x8*)(lds + PG8_SA(b, h) + aoff + m * 2048 + k * 1024); } while (0)
#define PG8_LDB(dst, b, h) do { _Pragma("unroll") for (int n = 0; n < 2; ++n) _Pragma("unroll") for (int k = 0; k < 2; ++k) dst[n][k] = *(const PG8_LAS bf16x8*)(lds + PG8_SB(b, h) + boff + n * 2048 + k * 1024); } while (0)
#define PG8_MMA(ai, bj, At, Bt) do { __builtin_amdgcn_s_setprio(1); _Pragma("unroll") for (int m = 0; m < 4; ++m) _Pragma("unroll") for (int n = 0; n < 2; ++n) _Pragma("unroll") for (int k = 0; k < 2; ++k) \
        acc[ai][bj][m][n] = __builtin_amdgcn_mfma_f32_16x16x32_bf16(Bt[n][k], At[m][k], acc[ai][bj][m][n], 0, 0, 0); __builtin_amdgcn_s_setprio(0); } while (0)
#define PG8_WAIT_V(n) asm volatile("s_waitcnt vmcnt(" #n ")" ::: "memory")
#define PG8_WAIT_L(n) asm volatile("s_waitcnt lgkmcnt(" #n ")" ::: "memory")
#define PG8_BAR __builtin_amdgcn_s_barrier()
#define PG8_SCHED __builtin_amdgcn_sched_barrier(0)
    Unit cur, nxt; int ui = 0;
    if (!S.next(0, cur)) return;
    f32x4 acc[2][2][4][2];
#pragma unroll
    for (int a = 0; a < 2; ++a)
#pragma unroll
        for (int b = 0; b < 2; ++b)
#pragma unroll
            for (int m = 0; m < 4; ++m)
#pragma unroll
                for (int n = 0; n < 2; ++n) acc[a][b][m][n] = (f32x4){0.f, 0.f, 0.f, 0.f};
    bf16x8 At[4][2], B0[2][2], B1[2][2];
    const char* cA = (const char*)g.A + (size_t)cur.pm * tstepA + (g.amod ? (size_t)(cur.pn % g.amod) * K * 2 : (size_t)0); const char* cB = (const char*)g.Bt + (size_t)cur.pn * tstepB;
    S.a_ready(cur);
    typename PreOf<Epi, Epi::HAS_PRE>::type pre; if constexpr (Epi::HAS_PRE) pre = E.prefetch(cur, tid);
    if constexpr (SP2) {
        PG8_STAGE(PG8_SB(0, 0), cB, voffB); PG8_STAGE(PG8_SB(0, 1), cB + hstepB, voffB); PG8_STAGE(PG8_SA(0, 0), cA, voffA); PG8_STAGE(PG8_SA(0, 1), cA + hstepA, voffA);
        if (wr == 1) PG8_BAR;
        PG8_WAIT_V(2); PG8_BAR;
        PG8_STAGE(PG8_SB(1, 0), cB + kstep, voffB); PG8_STAGE(PG8_SA(1, 0), cA + kstep, voffA); PG8_STAGE(PG8_SB(1, 1), cB + hstepB + kstep, voffB);
        PG8_WAIT_V(6); PG8_BAR;
    } else {
        PG8_STAGE(PG8_SB(0, 0), cB, voffB); PG8_STAGE(PG8_SA(0, 0), cA, voffA); PG8_STAGE(PG8_SB(0, 1), cB + hstepB, voffB); PG8_STAGE(PG8_SA(0, 1), cA + hstepA, voffA);
        if (wr == 1) PG8_BAR;
        PG8_WAIT_V(4); PG8_BAR;
        PG8_STAGE(PG8_SB(1, 0), cB + kstep, voffB); PG8_STAGE(PG8_SA(1, 0), cA + kstep, voffA); PG8_STAGE(PG8_SB(1, 1), cB + hstepB + kstep, voffB);
        PG8_WAIT_V(6); PG8_BAR;
    }
    for (;;) {
        const bool has_next = S.next(ui + 1, nxt);
        const char* nA = has_next ? (const char*)g.A + (size_t)nxt.pm * tstepA + (g.amod ? (size_t)(nxt.pn % g.amod) * K * 2 : (size_t)0) : cA; const char* nB = has_next ? (const char*)g.Bt + (size_t)nxt.pn * tstepB : cB;
        for (int t = 0; t < nt; t += 2) {
            const bool last = (t == nt - 2);
            const char* a1 = cA + (size_t)(t + 1) * kstep;
            const char* a2 = last ? nA : cA + (size_t)(t + 2) * kstep; const char* b2 = last ? nB : cB + (size_t)(t + 2) * kstep;
            const char* a3 = a2 + kstep; const char* b3 = b2 + kstep;
            if (last && has_next) S.a_ready(nxt);
            if constexpr (SP2) {
            PG8_LDB(B0, 0, 0); PG8_LDB(B1, 0, 1); PG8_SCHED; PG8_LDA(At, 0, 0); PG8_STAGE(PG8_SA(1, 1), a1 + hstepA, voffA);
            PG8_WAIT_V(8); PG8_WAIT_L(0); PG8_BAR; PG8_MMA(0, 0, At, B0); PG8_MMA(0, 1, At, B1); PG8_BAR; PG8_SCHED;
            PG8_LDA(At, 0, 1); PG8_STAGE(PG8_SB(0, 0), b2, voffB); PG8_STAGE(PG8_SB(0, 1), b2 + hstepB, voffB); PG8_STAGE(PG8_SA(0, 0), a2, voffA);
            PG8_WAIT_V(8); PG8_WAIT_L(0); PG8_BAR; PG8_MMA(1, 0, At, B0); PG8_MMA(1, 1, At, B1); PG8_BAR; PG8_SCHED;
            PG8_LDB(B0, 1, 0); PG8_LDB(B1, 1, 1); PG8_SCHED; PG8_LDA(At, 1, 0); PG8_STAGE(PG8_SA(0, 1), a2 + hstepA, voffA);
            PG8_WAIT_V(8); PG8_WAIT_L(0); PG8_BAR; PG8_MMA(0, 0, At, B0); PG8_MMA(0, 1, At, B1); PG8_BAR; PG8_SCHED;
            PG8_LDA(At, 1, 1); PG8_STAGE(PG8_SB(1, 0), b3, voffB); PG8_STAGE(PG8_SB(1, 1), b3 + hstepB, voffB); PG8_STAGE(PG8_SA(1, 0), a3, voffA);
            PG8_WAIT_V(8); PG8_WAIT_L(0); PG8_BAR; PG8_MMA(1, 0, At, B0); PG8_MMA(1, 1, At, B1); PG8_BAR; PG8_SCHED;
            } else {
            PG8_LDB(B0, 0, 0); PG8_SCHED; PG8_LDA(At, 0, 0); PG8_STAGE(PG8_SA(1, 1), a1 + hstepA, voffA);
            PG8_WAIT_L(8); PG8_BAR; PG8_WAIT_L(0); PG8_MMA(0, 0, At, B0); PG8_BAR; PG8_SCHED;
            PG8_LDB(B1, 0, 1); PG8_STAGE(PG8_SB(0, 0), b2, voffB);
            PG8_BAR; PG8_WAIT_L(0); PG8_MMA(0, 1, At, B1); PG8_BAR;
            PG8_LDA(At, 0, 1); PG8_STAGE(PG8_SA(0, 0), a2, voffA);
            PG8_BAR; PG8_WAIT_L(0); PG8_MMA(1, 0, At, B0); PG8_BAR; PG8_SCHED;
            PG8_STAGE(PG8_SB(0, 1), b2 + hstepB, voffB);
            PG8_WAIT_V(6); PG8_BAR; PG8_MMA(1, 1, At, B1); PG8_BAR;
            PG8_LDB(B0, 1, 0); PG8_SCHED; PG8_LDA(At, 1, 0); PG8_STAGE(PG8_SA(0, 1), a2 + hstepA, voffA);
            PG8_WAIT_L(8); PG8_BAR; PG8_WAIT_L(0); PG8_MMA(0, 0, At, B0); PG8_BAR; PG8_SCHED;
            PG8_LDB(B1, 1, 1); PG8_STAGE(PG8_SB(1, 0), b3, voffB);
            PG8_BAR; PG8_WAIT_L(0); PG8_MMA(0, 1, At, B1); PG8_BAR;
            PG8_LDA(At, 1, 1); PG8_STAGE(PG8_SA(1, 0), a3, voffA);
            PG8_BAR; PG8_WAIT_L(0); PG8_MMA(1, 0, At, B0); PG8_BAR; PG8_SCHED;
            PG8_STAGE(PG8_SB(1, 1), b3 + hstepB, voffB);
            PG8_WAIT_V(6); PG8_BAR; PG8_MMA(1, 1, At, B1); PG8_BAR;
            }
        }
        if constexpr (ALIGN_EPI) { if (wr == 0) PG8_BAR; }
        if constexpr (!Epi::AFTER_DRAIN) { if constexpr (Epi::HAS_PRE) E(acc, cur, wr, wc, fr, fq, pre, lds, tid); else E(acc, cur, wr, wc, fr, fq); S.done(cur); }
        if (!has_next) break;
#pragma unroll
        for (int a = 0; a < 2; ++a)
#pragma unroll
            for (int b = 0; b < 2; ++b)
#pragma unroll
                for (int m = 0; m < 4; ++m)
#pragma unroll
                    for (int n = 0; n < 2; ++n) acc[a][b][m][n] = (f32x4){0.f, 0.f, 0.f, 0.f};
        cur = nxt; cA = nA; cB = nB; ++ui;
        if constexpr (Epi::HAS_PRE) pre = E.prefetch(cur, tid);
        if constexpr (ALIGN_EPI) { if (wr == 1) PG8_BAR; }
    }
    PG8_WAIT_V(0);
    if constexpr (!ALIGN_EPI) { if (wr == 0) PG8_BAR; }
    PG8_BAR;
    if constexpr (Epi::AFTER_DRAIN) { E.fused(acc, cur, wr, wc, fr, fq, lds, wid, lane); S.done(cur); }
#undef PG8_SA
#undef PG8_SB
#undef PG8_STAGE
#undef PG8_LDA
#undef PG8_LDB
#undef PG8_MMA
#undef PG8_WAIT_V
#undef PG8_WAIT_L
#undef PG8_BAR
#undef PG8_SCHED
}
}

#ifndef PG8_SP2
#define PG8_SP2 true
#endif
#ifndef PG8_ALIGN
#define PG8_ALIGN true
#endif

constexpr int NWAVES = 8, NTHR = 512;
constexpr int DM = 2048, TSEQ = 4096, NBATCH = 2, MP = NBATCH * TSEQ, SB = 8, ST = 4, MS = SB * ST, MT = MP + MS, DEPTH = 4;
constexpr int NQKV = 9216, AW = 1024, FF2 = 12288, FF = 6144;
constexpr float RMS_EPS = 1e-6f;
enum { I_XP = 0, I_XS, I_C128, I_C512, I_C2048, I_SLH, I_SLC, I_SFC, I_NMIX, I_NFFN, I_NFIN, I_LWIN, I_LBIN, I_LCW, I_LCB, I_LWA, I_LBA, I_LWI, I_LBI, I_LLAM, I_LWOUT, I_LBOUT, I_AWQKV, I_AWO, I_FWUP, I_FCW, I_FCB, I_FWDN, N_IN };
constexpr size_t O_YP = 0, O_YS = O_YP + (size_t)MP * DM, O_KVP0 = O_YS + (size_t)MS * DM, O_KVP1 = O_KVP0 + (size_t)2 * 2 * 128 * 2048, O_KVP2 = O_KVP1 + (size_t)2 * 2 * 512 * 2048,
                 O_LHP = O_KVP2 + (size_t)2 * 2 * 2048 * 2048, O_LCP = O_LHP + (size_t)2 * 2 * 2048, O_FCP = O_LCP + (size_t)2 * 2 * 3 * 2048, O_KVS0 = O_FCP + (size_t)4 * 2 * 2 * FF2,
                 O_KVS1 = O_KVS0 + (size_t)2 * 8 * 4 * 2048, O_KVS2 = O_KVS1 + (size_t)2 * 8 * 4 * 2048, O_LHS = O_KVS2 + (size_t)2 * 8 * 4 * 2048, O_LCS = O_LHS + (size_t)2 * 8 * 2048,
                 O_FCS = O_LCS + (size_t)2 * 8 * 3 * 2048, O_END = O_FCS + (size_t)4 * 8 * 2 * FF2;
static_assert(O_END == 40402944, "output size");

constexpr size_t MiB = 1u << 20;
constexpr size_t WS_CTL = 0, CTL_ZERO_BYTES = 32 * 1024;
constexpr size_t WS_MISC = 1 * MiB;
constexpr size_t WS_WIN = 2 * MiB;
constexpr size_t WS_WOUT = WS_WIN + 32 * MiB;
constexpr size_t WS_GT = WS_WOUT + 16 * MiB;
constexpr size_t WS_WQKV = WS_GT + 4 * MiB;
constexpr size_t WS_WO = WS_WQKV + 72 * MiB;
constexpr size_t WS_WUP = WS_WO + 8 * MiB;
constexpr size_t WS_WDN = WS_WUP + 192 * MiB;
constexpr size_t WS_X = WS_WDN + 96 * MiB;
constexpr size_t WS_XN = WS_X + 65 * MiB;
constexpr size_t WS_SC = WS_XN + 33 * MiB;
constexpr size_t WS_S = WS_SC + 3 * MiB;
constexpr size_t S_GG = 0, S_U = 33 * MiB, S_UC = 66 * MiB, S_HG = 99 * MiB, S_LA = 132 * MiB, S_GI = 197 * MiB;
constexpr size_t S_QKV = 0, S_OG = 145 * MiB, S_LSE = 242 * MiB, S_O = 243 * MiB;
constexpr size_t S_UPS = 0, S_HB = 1 * MiB, S_ACT = 193 * MiB;
constexpr size_t WS_SSP = WS_S + 290 * MiB;
constexpr size_t WS_SSS = WS_SSP + 3 * MiB;
constexpr size_t WS_END = WS_SSS + 1 * MiB;
static_assert((size_t)MT * NQKV * 2 <= 145 * MiB && (size_t)3 * MT * AW * 4 <= 97 * MiB && (size_t)MT * FF * 2 <= 97 * MiB && (size_t)MT * DM * 4 <= 65 * MiB && (size_t)MT * DM * 2 <= 33 * MiB, "d_ws map");
constexpr int CW_TMO = 0, CW_CODE = 1, CW_BAR = 4096;
static_assert((size_t)(CW_BAR + 3456) * 4 <= CTL_ZERO_BYTES, "barrier words inside the per-call memset");

constexpr int RING_OFF = 0, RING_BYTES = 147456;
constexpr int LDSCTL_OFF = RING_BYTES, MISC_OFF = LDSCTL_OFF + 320;
constexpr int LDS_BYTES = 148480;
constexpr int EPI_T_OFF = 131072;
static_assert(MISC_OFF + 128 <= LDS_BYTES, "LDS map");

#define GAS __attribute__((address_space(1)))
#define LAS __attribute__((address_space(3)))
typedef unsigned short bf16;
typedef unsigned v4u __attribute__((ext_vector_type(4)));
typedef unsigned v2u __attribute__((ext_vector_type(2)));
typedef float f32x4 __attribute__((ext_vector_type(4)));
typedef float f32x2 __attribute__((ext_vector_type(2)));
typedef short bf16x8 __attribute__((ext_vector_type(8)));
typedef GAS unsigned gu32;
#define RLX_AGENT __ATOMIC_RELAXED, __HIP_MEMORY_SCOPE_AGENT
#define LDS_WAIT() asm volatile("s_waitcnt lgkmcnt(0)" ::: "memory")
#define VM_WAIT() asm volatile("s_waitcnt vmcnt(0)" ::: "memory")
using pg8::cvt_pk_bf16; using pg8::gelu_tanh; using pg8::sigmoid_f; using pg8::bf_lo; using pg8::bf_hi;
__device__ __forceinline__ bf16 f2bf1(float f) { return (bf16)(cvt_pk_bf16(f, 0.f) & 0xffffu); }
__device__ __forceinline__ float bf2f(bf16 b) { return __uint_as_float((unsigned)b << 16); }
__device__ __forceinline__ void unpack8(const v4u w, float (&f)[8]) { f[0] = bf_lo(w.x); f[1] = bf_hi(w.x); f[2] = bf_lo(w.y); f[3] = bf_hi(w.y); f[4] = bf_lo(w.z); f[5] = bf_hi(w.z); f[6] = bf_lo(w.w); f[7] = bf_hi(w.w); }
__device__ __forceinline__ v4u pack8(const float (&f)[8]) { v4u w; w.x = cvt_pk_bf16(f[0], f[1]); w.y = cvt_pk_bf16(f[2], f[3]); w.z = cvt_pk_bf16(f[4], f[5]); w.w = cvt_pk_bf16(f[6], f[7]); return w; }
__device__ __forceinline__ void load8f(const float* p, float (&f)[8]) { const f32x4 a = *(const f32x4*)p, b = *(const f32x4*)(p + 4); f[0] = a[0]; f[1] = a[1]; f[2] = a[2]; f[3] = a[3]; f[4] = b[0]; f[5] = b[1]; f[6] = b[2]; f[7] = b[3]; }
__device__ __forceinline__ void store8f(float* p, const float (&f)[8]) { *(f32x4*)p = (f32x4){f[0], f[1], f[2], f[3]}; *(f32x4*)(p + 4) = (f32x4){f[4], f[5], f[6], f[7]}; }
using pg8::xshf; using pg8::half_sum; using pg8::half_max; using pg8::rstd_ss; using pg8::rstd_row8;
__device__ __forceinline__ float wave_sum(float v) { v += xshf<1>(v); v += xshf<2>(v); v += xshf<4>(v); v += xshf<8>(v); v += xshf<16>(v); return half_sum(v); }
__device__ __forceinline__ float wave_max(float v) { v = fmaxf(v, xshf<1>(v)); v = fmaxf(v, xshf<2>(v)); v = fmaxf(v, xshf<4>(v)); v = fmaxf(v, xshf<8>(v)); v = fmaxf(v, xshf<16>(v)); return half_max(v); }
__device__ __forceinline__ int lane_id() { int l; asm volatile("v_mbcnt_lo_u32_b32 %0, -1, 0\n\tv_mbcnt_hi_u32_b32 %0, -1, %0" : "=v"(l)); return l; }
#define XB_TMO      128
#define XB_XCNT(j)  (256  + 64 * (j))
#define XB_XSUB(j)  (1280 + 64 * (j))
#define XB_XGEN(j)  (2304 + 64 * (j))
#define XB_TOP      3328
#define XB_TOPGEN   3392
#define XCD_BAR_WORDS 3456
#define XB_SPIN_CAP (1u << 18)

__device__ __forceinline__ unsigned xb_ld(unsigned* p)              { return __hip_atomic_load(p, __ATOMIC_RELAXED, __HIP_MEMORY_SCOPE_AGENT); }
__device__ __forceinline__ unsigned xb_add(unsigned* p, unsigned v) { return __hip_atomic_fetch_add(p, v, __ATOMIC_RELAXED, __HIP_MEMORY_SCOPE_AGENT); }
__device__ __forceinline__ unsigned xb_xcc_id() { return (unsigned)__builtin_amdgcn_s_getreg((3 << 11) | 20) & 0xFu; }
#define XB_SPIN(cond, bar) do { unsigned _sp = 0; while (cond) { __builtin_amdgcn_s_sleep(1); \
    if ((++_sp & 255u) == 0u) { if (xb_ld(&(bar)[XB_TMO])) break; if (_sp > XB_SPIN_CAP) { atomicAdd(&(bar)[XB_TMO], 1u); break; } } } } while (0)

struct XcdBarrier {
    unsigned* bar; unsigned x; int wv;
    volatile LAS unsigned* st;
};

__device__ __forceinline__ bool xb_thread0(int wv) { return wv == 0 && lane_id() == 0; }
__device__ __forceinline__ XcdBarrier xcd_barrier_post(unsigned* bar, volatile LAS unsigned* st, int wv) {
    XcdBarrier b; b.bar = bar; b.x = xb_xcc_id(); b.st = st; b.wv = wv;
    if (xb_thread0(wv)) (void)xb_add(&bar[XB_XCNT(b.x)], 1u);
    return b;
}
__device__ __forceinline__ void xcd_barrier_complete(unsigned* bar, unsigned x, unsigned& nloc, unsigned& nx) {
    const unsigned G = gridDim.x * gridDim.y * gridDim.z;
    unsigned sum, cnt, mine, sp = 0u;
    for (;;) {
        sum = 0u; cnt = 0u; mine = 0u;
#pragma unroll
        for (unsigned j = 0; j < 16; ++j) { const unsigned c = xb_ld(&bar[XB_XCNT(j)]); sum += c; cnt += (c > 0u) ? 1u : 0u; mine = (j == x) ? c : mine; }
        if (sum == G) break;
        __builtin_amdgcn_s_sleep(1);
        if ((++sp & 255u) == 0u) { if (xb_ld(&bar[XB_TMO])) break; if (sp > XB_SPIN_CAP) { atomicAdd(&bar[XB_TMO], 1u); break; } }
    }
    nloc = mine > 0u ? mine : 1u; nx = cnt > 0u ? cnt : 1u;
}

__device__ __forceinline__ void xcd_barrier(const XcdBarrier& b) {
    asm volatile("s_waitcnt vmcnt(0)" ::: "memory");
    __syncthreads();
    if (xb_thread0(b.wv)) {
        unsigned* bar = b.bar;
        __builtin_amdgcn_s_waitcnt(0);
        unsigned nloc = b.st[0], nx = b.st[1];
        if (nloc == 0u) { xcd_barrier_complete(bar, b.x, nloc, nx); b.st[0] = nloc; b.st[1] = nx; }
        const unsigned old = xb_add(&bar[XB_XSUB(b.x)], 1u);
        const unsigned gen = old / nloc;
        if (old + 1u == (gen + 1u) * nloc) {
            __builtin_amdgcn_fence(__ATOMIC_RELEASE, "agent");
            asm volatile("s_waitcnt vmcnt(0)" ::: "memory");
            const unsigned og = xb_add(&bar[XB_TOP], 1u);
            const unsigned tg = og / nx;
            if (og + 1u == (tg + 1u) * nx) xb_add(&bar[XB_TOPGEN], 1u);
            else XB_SPIN(xb_ld(&bar[XB_TOPGEN]) == tg, bar);
            __builtin_amdgcn_fence(__ATOMIC_ACQUIRE, "agent");
            xb_add(&bar[XB_XGEN(b.x)], 1u);
            asm volatile("s_waitcnt vmcnt(0)" ::: "memory");
        } else {
            XB_SPIN(xb_ld(&bar[XB_XGEN(b.x)]) == gen, bar);
            __builtin_amdgcn_fence(__ATOMIC_ACQUIRE, "agent");
            asm volatile("s_waitcnt vmcnt(0)" ::: "memory");
        }
    }
    __syncthreads();
}

struct Args { const float* in[N_IN]; float* out; unsigned char* ws; };
typedef __attribute__((address_space(4))) const Args CArgs;
__device__ __forceinline__ CArgs* kargs() { CArgs* p = (CArgs*)__builtin_amdgcn_kernarg_segment_ptr(); asm volatile("" : "+s"(p)); return p; }
struct Frame {
    LAS unsigned char* lds;
    int tid, lane, wave, G, bx;
    int gw, ngw, gt, ngt;
};

__device__ __forceinline__ Frame mk_frame(LAS unsigned char* lds, int wv) {
    Frame F; asm volatile("" : "+s"(wv)); const int lane = lane_id(); const int tid = wv * 64 + lane;
    F.lds = lds; F.tid = tid; F.lane = lane; F.wave = wv;
    int G_ = gridDim.x, bx_ = blockIdx.x; asm volatile("" : "+s"(G_), "+s"(bx_)); F.G = G_; F.bx = bx_;
    F.gw = F.bx * NWAVES + F.wave; F.ngw = F.G * NWAVES; F.gt = F.bx * NTHR + tid; F.ngt = F.G * NTHR;
    return F;
}

template <int GLU = 0>
__device__ __forceinline__ void p0_transpose_item(const float* W, int K, int N, bf16* WT, LAS float* scr, int item, int lane, const float* gain = nullptr) {
    const int nblk = N / 32, kb = item / nblk, nb = item % nblk, k0 = 128 * kb, n0 = 32 * nb;
    const int nd0 = GLU ? (n0 < 6144 ? 256 * (n0 >> 7) + (n0 & 127) : 256 * ((n0 - 6144) >> 7) + 128 + ((n0 - 6144) & 127)) : n0;
#pragma unroll 32
    for (int i = 0; i < 64; ++i) { const int kk = 2 * i + (lane >> 5); scr[kk * 33 + (lane & 31)] = W[(size_t)(k0 + kk) * N + n0 + (lane & 31)]; }
    LDS_WAIT(); asm volatile("" ::: "memory");
    const int c = lane & 15;
    float gk[8];
    if (gain) load8f(gain + k0 + 8 * c, gk); else {
#pragma unroll
        for (int e = 0; e < 8; ++e) gk[e] = 1.0f; }
#pragma unroll
    for (int j = 0; j < 8; ++j) { const int n = (lane >> 4) + 4 * j; const LAS float* s = scr + (8 * c) * 33 + n;
        v4u o; o.x = cvt_pk_bf16(s[0 * 33] * gk[0], s[1 * 33] * gk[1]); o.y = cvt_pk_bf16(s[2 * 33] * gk[2], s[3 * 33] * gk[3]); o.z = cvt_pk_bf16(s[4 * 33] * gk[4], s[5 * 33] * gk[5]); o.w = cvt_pk_bf16(s[6 * 33] * gk[6], s[7 * 33] * gk[7]);
        *(GAS v4u*)(WT + (size_t)(nd0 + n) * K + k0 + 8 * c) = o; }
    LDS_WAIT(); asm volatile("" ::: "memory");
}
__device__ __forceinline__ void rows_to_bf16_ss(const Frame& F, const float* xp, const float* xs, bf16* XB, float* SSP, float* SSS) {
#pragma unroll 2
    for (int m = F.gw; m < MT; m += F.ngw) {
        const float* src = (m < MP) ? xp + (size_t)m * DM : xs + (size_t)(m - MP) * DM;
        const GAS f32x4* xr = (const GAS f32x4*)src + F.lane;
        f32x4 v[8]; float s = 0.f;
#pragma unroll
        for (int j = 0; j < 8; ++j) { v[j] = xr[64 * j]; s += (v[j].x * v[j].x + v[j].y * v[j].y) + (v[j].z * v[j].z + v[j].w * v[j].w); }
        s = wave_sum(s);
        GAS v2u* o8 = (GAS v2u*)(XB + (size_t)m * DM) + F.lane;
#pragma unroll
        for (int j = 0; j < 8; ++j) { v2u w; w.x = cvt_pk_bf16(v[j].x, v[j].y); w.y = cvt_pk_bf16(v[j].z, v[j].w); o8[64 * j] = w; }
        if (m < MP) { if (F.lane < 8) SSP[(size_t)m * 8 + F.lane] = F.lane == 0 ? s : 0.f; } else { *(f32x2*)(SSS + (size_t)(m - MP) * 128 + 2 * F.lane) = (f32x2){F.lane == 0 ? s : 0.f, 0.f}; }
    }
}
__device__ __forceinline__ void norm_rows_out(const Frame& F, const bf16* XB, const float* g, float* yp, float* ys) {
#pragma unroll 2
    for (int m = F.gw; m < MT; m += F.ngw) {
        const GAS v4u* xr = (const GAS v4u*)(XB + (size_t)m * DM) + F.lane;
        float v[4][8]; float s = 0.f;
#pragma unroll
        for (int j = 0; j < 4; ++j) { unpack8(xr[64 * j], v[j]);
#pragma unroll
            for (int e = 0; e < 8; ++e) s += v[j][e] * v[j][e]; }
        const float rstd = __builtin_amdgcn_rsqf(wave_sum(s) * (1.0f / DM) + RMS_EPS);
        float* dst = (m < MP) ? yp + (size_t)m * DM : ys + (size_t)(m - MP) * DM;
#pragma unroll
        for (int j = 0; j < 4; ++j) { float gg[8], o[8]; load8f(g + 512 * j + 8 * F.lane, gg);
#pragma unroll
            for (int e = 0; e < 8; ++e) o[e] = v[j][e] * rstd * gg[e];
            store8f(dst + 512 * j + 8 * F.lane, o); }
    }
}

__device__ __forceinline__ void p0_prologue(const Frame& F, CArgs* A, unsigned char* ws) {
    LAS float* scr = (LAS float*)(F.lds + RING_OFF + F.wave * 17408);
    bf16* WIN = (bf16*)(ws + WS_WIN); bf16* WOUT = (bf16*)(ws + WS_WOUT); bf16* GT = (bf16*)(ws + WS_GT); bf16* WQKV = (bf16*)(ws + WS_WQKV);
    bf16* WO = (bf16*)(ws + WS_WO); bf16* WUP = (bf16*)(ws + WS_WUP); bf16* WDN = (bf16*)(ws + WS_WDN);
    constexpr int IP_UP = (DM / 128) * (FF2 / 32), IP_DN = (FF / 128) * (DM / 32), IP_QKV = (DM / 128) * (NQKV / 32), IP_IN = (DM / 128) * (4096 / 32), IP_OUT = (DM / 128) * (DM / 32), IP_WO = (AW / 128) * (DM / 32), IP_G = (256 / 128) * (256 / 32);
    constexpr int NITEMS = 4 * IP_UP + 4 * IP_DN + 2 * IP_QKV + 2 * IP_IN + 2 * IP_OUT + 2 * IP_WO + 32 * IP_G;
#define P0_SEG(COUNT, IPM, CALL) if (r < (COUNT) * (IPM)) { const int mi = r / (IPM), item = r % (IPM); (void)mi; CALL; continue; } r -= (COUNT) * (IPM);
#define P0_UP(mat) p0_transpose_item<1>(A->in[I_FWUP] + (size_t)(mat) * DM * FF2, DM, FF2, WUP + (size_t)(mat) * DM * FF2, scr, item, F.lane, A->in[I_NFFN] + (size_t)(mat) * DM)
#define P0_DN(mat) p0_transpose_item(A->in[I_FWDN] + (size_t)(mat) * DM * FF, FF, DM, WDN + (size_t)(mat) * DM * FF, scr, item, F.lane)
#define P0_QKV(mat) p0_transpose_item(A->in[I_AWQKV] + (size_t)(mat) * DM * NQKV, DM, NQKV, WQKV + (size_t)(mat) * DM * NQKV, scr, item, F.lane, A->in[I_NMIX] + (size_t)(2 * (mat) + 1) * DM)
#define P0_IN(mat) p0_transpose_item(A->in[I_LWIN] + (size_t)(mat) * DM * 4096, DM, 4096, WIN + (size_t)(mat) * DM * 4096, scr, item, F.lane, A->in[I_NMIX] + (size_t)(2 * (mat)) * DM)
#define P0_OUT(mat) p0_transpose_item(A->in[I_LWOUT] + (size_t)(mat) * DM * DM, DM, DM, WOUT + (size_t)(mat) * DM * DM, scr, item, F.lane)
#define P0_WO(mat) p0_transpose_item(A->in[I_AWO] + (size_t)(mat) * AW * DM, AW, DM, WO + (size_t)(mat) * AW * DM, scr, item, F.lane)
    for (int it = F.gw; it < NITEMS; it += F.ngw) {
        int r = it;
        P0_SEG(3, IP_DN, P0_DN(3 - mi)) P0_SEG(3, IP_UP, P0_UP(3 - mi))
        P0_SEG(1, IP_QKV, P0_QKV(1)) P0_SEG(1, IP_WO, P0_WO(1)) P0_SEG(1, IP_IN, P0_IN(1)) P0_SEG(1, IP_OUT, P0_OUT(1))
        P0_SEG(1, IP_QKV, P0_QKV(0)) P0_SEG(1, IP_WO, P0_WO(0))
        P0_SEG(1, IP_DN, P0_DN(0)) P0_SEG(1, IP_UP, P0_UP(0))
        if (r < 32 * IP_G) { const int gate = r / (16 * IP_G); const int rr = r % (16 * IP_G); const int mat = rr / IP_G;
          p0_transpose_item(A->in[gate ? I_LWI : I_LWA] + (size_t)mat * 65536, 256, 256, GT + (size_t)(mat >> 3) * (4096 * 256) + (size_t)gate * (2048 * 256) + (size_t)(mat & 7) * 65536, scr, rr % IP_G, F.lane); continue; } r -= 32 * IP_G;
        P0_SEG(1, IP_OUT, P0_OUT(0)) P0_SEG(1, IP_IN, P0_IN(0))
    }
    if (F.gt < 2 * 2048) { float* SP = (float*)(ws + WS_MISC); SP[F.gt] = log1pf(expf(-A->in[I_LLAM][F.gt])); }
    rows_to_bf16_ss(F, A->in[I_XP], A->in[I_XS], (bf16*)(ws + WS_XN), (float*)(ws + WS_SSP), (float*)(ws + WS_SSS));
}

template <int NB, int UNR = 8, class Fn>
__device__ __forceinline__ void thin_gemm(const Frame& F, const bf16* A, int lda, int amod, const bf16* Bt, int N, int K, const Fn& fn, const float* sss = nullptr) {
    LAS float* red = (LAS float*)(F.lds + RING_OFF);
    const int fr = F.lane & 15, fq = F.lane >> 4;
    const int kper = K >> 3, k0 = F.wave * kper;
    float rsd = 1.0f;
    if (sss) { const float* p = sss + (size_t)(F.tid >> 4) * 128 + (F.tid & 15) * 8; const f32x4 a = *(const f32x4*)p, b = *(const f32x4*)(p + 4);
        float t = ((a[0] + a[1]) + (a[2] + a[3])) + ((b[0] + b[1]) + (b[2] + b[3])); t += xshf<1>(t); t += xshf<2>(t); t += xshf<4>(t); t += xshf<8>(t); rsd = rstd_ss(t); }
    const int nitems = N / 16; constexpr int nb = NB;
    for (int it0 = F.bx; it0 < nitems; it0 += nb * F.G) {
        const int it1 = it0 + F.G, it2 = it0 + 2 * F.G; const bool v1 = nb > 1 && it1 < nitems, v2 = nb > 1 && it2 < nitems;
        const int n0 = it0 * 16, n1 = (v1 ? it1 : it0) * 16, n2 = (v2 ? it2 : it0) * 16;
        const int acol = amod ? ((n0 >> 8) % amod) * K : 0;
        const bf16* ap0 = A + (size_t)fr * lda + acol + k0 + 8 * fq;
        const bf16* ap1 = ap0 + (size_t)16 * lda;
        const bf16* bp0 = Bt + (size_t)(n0 + fr) * K + k0 + 8 * fq; const bf16* bp1 = Bt + (size_t)(n1 + fr) * K + k0 + 8 * fq; const bf16* bp2 = Bt + (size_t)(n2 + fr) * K + k0 + 8 * fq;
        f32x4 acc[NB][2];
#pragma unroll
        for (int j = 0; j < NB; ++j) { acc[j][0] = (f32x4){0.f, 0.f, 0.f, 0.f}; acc[j][1] = (f32x4){0.f, 0.f, 0.f, 0.f}; }
#pragma unroll UNR
        for (int s = 0; s < kper; s += 32) {
            const bf16x8 a0 = *(const bf16x8*)(ap0 + s), a1 = *(const bf16x8*)(ap1 + s), b0 = *(const bf16x8*)(bp0 + s);
            acc[0][0] = __builtin_amdgcn_mfma_f32_16x16x32_bf16(a0, b0, acc[0][0], 0, 0, 0); acc[0][1] = __builtin_amdgcn_mfma_f32_16x16x32_bf16(a1, b0, acc[0][1], 0, 0, 0);
            if constexpr (NB > 1) { const bf16x8 b1 = *(const bf16x8*)(bp1 + s), b2 = *(const bf16x8*)(bp2 + s);
                acc[1][0] = __builtin_amdgcn_mfma_f32_16x16x32_bf16(a0, b1, acc[1][0], 0, 0, 0); acc[1][1] = __builtin_amdgcn_mfma_f32_16x16x32_bf16(a1, b1, acc[1][1], 0, 0, 0);
                acc[2][0] = __builtin_amdgcn_mfma_f32_16x16x32_bf16(a0, b2, acc[2][0], 0, 0, 0); acc[2][1] = __builtin_amdgcn_mfma_f32_16x16x32_bf16(a1, b2, acc[2][1], 0, 0, 0); }
        }
#pragma unroll
        for (int j = 0; j < NB; ++j)
#pragma unroll
            for (int r = 0; r < 4; ++r) { red[j * 4096 + F.wave * 512 + (4 * fq + r) * 16 + fr] = acc[j][0][r]; red[j * 4096 + F.wave * 512 + (16 + 4 * fq + r) * 16 + fr] = acc[j][1][r]; }
        __syncthreads();
#pragma unroll
        for (int j = 0; j < NB; ++j) { if (j == 0 || (j == 1 && v1) || (j == 2 && v2)) { float v = 0.f;
#pragma unroll
            for (int w = 0; w < 8; ++w) v += red[j * 4096 + w * 512 + F.tid];
            fn(F.tid >> 4, (j == 0 ? n0 : (j == 1 ? n1 : n2)) + (F.tid & 15), v * rsd); } }
        __syncthreads();
    }
}
struct TWin { bf16* GG; bf16* U; const float* bias;
    __device__ __forceinline__ void operator()(int r, int c, float v) const { v += bias[c]; if (c < 2048) GG[(size_t)(MP + r) * 2048 + c] = f2bf1(gelu_tanh(v)); else U[(size_t)(MP + r) * 2048 + c - 2048] = f2bf1(v); } };
struct TGates { bf16* OMA; bf16* GI; const bf16* UC; const float* b_a; const float* b_i; const float* sp;
    __device__ __forceinline__ void operator()(int r, int c, float v) const {
        if (c < 2048) OMA[(size_t)(MP + r) * 2048 + c] = f2bf1(1.0f - __builtin_amdgcn_exp2f(sigmoid_f(v + b_a[c]) * sp[c] * (-8.0f * 1.4426950409f)));
        else { c -= 2048; GI[(size_t)(MP + r) * 2048 + c] = f2bf1(sigmoid_f(v + b_i[c]) * bf2f(UC[(size_t)(MP + r) * 2048 + c])); } } };
struct TResid { bf16* XB; const float* bias; float* SSS;
    __device__ __forceinline__ void operator()(int r, int c, float v) const { const bf16 ob = f2bf1(bf2f(XB[(size_t)r * 2048 + c]) + v + (bias ? bias[c] : 0.f)); XB[(size_t)r * 2048 + c] = ob; const float o = bf2f(ob);
        float ss = o * o; ss += xshf<1>(ss); ss += xshf<2>(ss); ss += xshf<4>(ss); ss += xshf<8>(ss);
        if ((c & 15) == 0) SSS[(size_t)r * 128 + (c >> 4)] = ss; } };
struct TQkv { bf16* QKV; float* kvs0; int j;
    __device__ __forceinline__ void operator()(int r, int c, float v) const {
        QKV[(size_t)r * NQKV + c] = f2bf1(v);
        const int g = c / 3072, rem = c - g * 3072, part = rem >> 10;
        if (part) kvs0[(size_t)g * (O_KVS1 - O_KVS0) + ((size_t)(j * 32 + r) * 2 + (part - 1)) * 1024 + (rem & 1023)] = v; } };
struct TUp { bf16* UPS;
    __device__ __forceinline__ void operator()(int r, int c, float v) const { const int tl = c >> 8, x = c & 255; const int nat = x < 128 ? 128 * tl + x : 6144 + 128 * tl + (x - 128); UPS[(size_t)r * FF2 + nat] = f2bf1(v); } };

__device__ __forceinline__ void lru_conv_own(const Frame& F, CArgs* A, int j, const bf16* U, bf16* UC) {
    const float* cw = A->in[I_LCW] + (size_t)j * 4 * 2048; const float* cb = A->in[I_LCB] + (size_t)j * 2048; const float* st = A->in[I_SLC] + (size_t)j * SB * 3 * 2048;
    for (int P = F.bx; P < 256; P += F.G) {
        const int pm = P >> 3, hd = P & 7, c = hd * 256 + (F.tid & 31) * 8, m0 = pm * 256 + (F.tid >> 5) * 16, t0 = m0 & 4095;
        float w[4][8], bias[8], x3[8], x2[8], x1[8];
#pragma unroll
        for (int k = 0; k < 4; ++k) load8f(cw + (size_t)k * 2048 + c, w[k]);
        load8f(cb + c, bias);
        if (t0 != 0) { unpack8(*(const v4u*)(U + (size_t)(m0 - 3) * 2048 + c), x3); unpack8(*(const v4u*)(U + (size_t)(m0 - 2) * 2048 + c), x2); unpack8(*(const v4u*)(U + (size_t)(m0 - 1) * 2048 + c), x1); }
        else {
#pragma unroll
            for (int e = 0; e < 8; ++e) { x3[e] = 0.f; x2[e] = 0.f; x1[e] = 0.f; } }
#pragma unroll
        for (int r = 0; r < 16; ++r) { float x0[8], o[8]; unpack8(*(const v4u*)(U + (size_t)(m0 + r) * 2048 + c), x0);
#pragma unroll
            for (int e = 0; e < 8; ++e) o[e] = bias[e] + w[0][e] * x3[e] + w[1][e] * x2[e] + w[2][e] * x1[e] + w[3][e] * x0[e];
            *(v4u*)(UC + (size_t)(m0 + r) * 2048 + c) = pack8(o);
            if (t0 + r >= TSEQ - 3) store8f(A->out + O_LCP + ((size_t)(j * 2 + (m0 >> 12)) * 3 + (t0 + r - (TSEQ - 3))) * 2048 + c, x0);
#pragma unroll
            for (int e = 0; e < 8; ++e) { x3[e] = x2[e]; x2[e] = x1[e]; x1[e] = x0[e]; } }
    }
    for (int it = F.bx; it < 256; it += F.G) {
        const int hd = (it >> 4) & 7;
#pragma unroll
        for (int q2 = 0; q2 < 2; ++q2) { const int q = F.tid + 512 * q2, row = q >> 5, c = hd * 256 + (q & 31) * 8, b = row >> 2, t = row & 3; const int m = MP + row;
            float acc[8], x0[8] = {0.f, 0.f, 0.f, 0.f, 0.f, 0.f, 0.f, 0.f}; load8f(cb + c, acc);
#pragma unroll
            for (int k = 0; k < 4; ++k) { const int d = 3 - k; float w[8], x[8]; load8f(cw + (size_t)k * 2048 + c, w);
                if (t >= d) unpack8(*(const v4u*)(U + (size_t)(m - d) * 2048 + c), x); else load8f(st + ((size_t)b * 3 + (t + 3 - d)) * 2048 + c, x);
#pragma unroll
                for (int e = 0; e < 8; ++e) acc[e] += w[e] * x[e];
                if (k == 3) {
#pragma unroll
                    for (int e = 0; e < 8; ++e) x0[e] = x[e]; } }
            *(v4u*)(UC + (size_t)m * 2048 + c) = pack8(acc);
            if (t >= 1) store8f(A->out + O_LCS + ((size_t)(j * SB + b) * 3 + (t - 1)) * 2048 + c, x0); }
    }
    VM_WAIT(); __syncthreads();
}
__device__ __forceinline__ float fsqrt(float x) { return __builtin_amdgcn_sqrtf(x); }
__device__ __forceinline__ void scan_pass1(const Frame& F, const bf16* OMA, const bf16* GI, float* CA, float* CB) {
    for (int it = F.bx; it < 256; it += F.G) {
        const int q = it & 1, ch = (it >> 1) & 63, b = it >> 7, col = q * 1024 + 2 * F.tid;
        const size_t base = ((size_t)b * TSEQ + ch * 64) * 2048 + col;
        float A0 = 1.f, B0 = 0.f, A1 = 1.f, B1 = 0.f;
        unsigned ow[2][16], gw[2][16];
#pragma unroll
        for (int k = 0; k < 16; ++k) { ow[0][k] = *(const unsigned*)(OMA + base + (size_t)k * 2048); gw[0][k] = *(const unsigned*)(GI + base + (size_t)k * 2048); }
#pragma unroll
        for (int bt = 0; bt < 4; ++bt) {
            if (bt < 3) {
#pragma unroll
                for (int k = 0; k < 16; ++k) { ow[(bt + 1) & 1][k] = *(const unsigned*)(OMA + base + (size_t)(16 * (bt + 1) + k) * 2048); gw[(bt + 1) & 1][k] = *(const unsigned*)(GI + base + (size_t)(16 * (bt + 1) + k) * 2048); } }
            __builtin_amdgcn_sched_barrier(0);
#pragma unroll
            for (int k = 0; k < 16; ++k) { const unsigned ow_ = ow[bt & 1][k], gw_ = gw[bt & 1][k]; const float o0 = bf_lo(ow_), o1 = bf_hi(ow_), a0 = 1.f - o0, a1 = 1.f - o1;
                A0 *= a0; B0 = a0 * B0 + fsqrt(o0 * (1.f + a0)) * bf_lo(gw_); A1 *= a1; B1 = a1 * B1 + fsqrt(o1 * (1.f + a1)) * bf_hi(gw_); }
            __builtin_amdgcn_sched_barrier(0);
        }
        *(f32x2*)(CA + (size_t)(b * 64 + ch) * 2048 + col) = (f32x2){A0, A1}; *(f32x2*)(CB + (size_t)(b * 64 + ch) * 2048 + col) = (f32x2){B0, B1};
    }
}
__device__ __forceinline__ void scan_pass2(const Frame& F, const float* CA, const float* CB, float* HIN) {
    LAS float* T = (LAS float*)(F.lds + RING_OFF);
    const int lc = F.tid & 63, g = F.wave;
    for (int it = F.bx; it < NBATCH * 32; it += F.G) {
        const int b = it >> 5, col = (it & 31) * 64 + lc;
        float a[8], c[8];
#pragma unroll
        for (int k = 0; k < 8; ++k) { const size_t i = (size_t)(b * 64 + g * 8 + k) * 2048 + col; a[k] = CA[i]; c[k] = CB[i]; }
        float Ag = 1.f, Bg = 0.f;
#pragma unroll
        for (int k = 0; k < 8; ++k) { Ag = a[k] * Ag; Bg = a[k] * Bg + c[k]; }
        *(LAS f32x2*)(T + (g * 64 + lc) * 2) = (f32x2){Ag, Bg};
        __syncthreads();
        float h = 0.f;
        for (int gg = 0; gg < g; ++gg) { const f32x2 t = *(const LAS f32x2*)(T + (gg * 64 + lc) * 2); h = t.x * h + t.y; }
#pragma unroll
        for (int k = 0; k < 8; ++k) { const size_t i = (size_t)(b * 64 + g * 8 + k) * 2048 + col; HIN[i] = h; h = a[k] * h + c[k]; }
        __syncthreads();
    }
}
__device__ __forceinline__ void scan_pass3(const Frame& F, CArgs* A, int j, const bf16* OMA, const bf16* GI, const float* HIN, const bf16* GG, bf16* HG) {
    for (int it = F.bx; it < 256; it += F.G) {
        const int q = it & 1, ch = (it >> 1) & 63, b = it >> 7, col = q * 1024 + 2 * F.tid;
        const size_t base = ((size_t)b * TSEQ + ch * 64) * 2048 + col;
        const f32x2 hin = *(const f32x2*)(HIN + (size_t)(b * 64 + ch) * 2048 + col); float h0 = hin.x, h1 = hin.y;
        unsigned ow[2][16], gw[2][16], ggw[2][16];
#pragma unroll
        for (int k = 0; k < 16; ++k) { const size_t i = base + (size_t)k * 2048; ow[0][k] = *(const unsigned*)(OMA + i); gw[0][k] = *(const unsigned*)(GI + i); ggw[0][k] = *(const unsigned*)(GG + i); }
#pragma unroll
        for (int bt = 0; bt < 4; ++bt) {
            if (bt < 3) {
#pragma unroll
                for (int k = 0; k < 16; ++k) { const size_t i = base + (size_t)(16 * (bt + 1) + k) * 2048; ow[(bt + 1) & 1][k] = *(const unsigned*)(OMA + i); gw[(bt + 1) & 1][k] = *(const unsigned*)(GI + i); ggw[(bt + 1) & 1][k] = *(const unsigned*)(GG + i); } }
            __builtin_amdgcn_sched_barrier(0);
#pragma unroll
            for (int k = 0; k < 16; ++k) { const size_t i = base + (size_t)(16 * bt + k) * 2048; const unsigned ow_ = ow[bt & 1][k], gw_ = gw[bt & 1][k], gg_ = ggw[bt & 1][k];
                const float o0 = bf_lo(ow_), o1 = bf_hi(ow_), a0 = 1.f - o0, a1 = 1.f - o1;
                h0 = a0 * h0 + fsqrt(o0 * (1.f + a0)) * bf_lo(gw_); h1 = a1 * h1 + fsqrt(o1 * (1.f + a1)) * bf_hi(gw_);
                *(unsigned*)(HG + i) = cvt_pk_bf16(h0 * bf_lo(gg_), h1 * bf_hi(gg_)); }
            __builtin_amdgcn_sched_barrier(0);
        }
        if (ch == 63) *(f32x2*)(A->out + O_LHP + (size_t)(j * 2 + b) * 2048 + col) = (f32x2){h0, h1};
    }
    for (int i = F.gt; i < SB * 2048; i += F.ngt) { const int b = i >> 11, col = i & 2047; float h = A->in[I_SLH][(size_t)(j * SB + b) * 2048 + col];
#pragma unroll
        for (int t = 0; t < ST; ++t) { const size_t k = (size_t)(MP + b * ST + t) * 2048 + col; const float o = bf2f(OMA[k]), a = 1.f - o; h = a * h + fsqrt(o * (1.f + a)) * bf2f(GI[k]); HG[k] = f2bf1(h * bf2f(GG[k])); }
        A->out[O_LHS + (size_t)(j * SB + b) * 2048 + col] = h; }
}
__device__ __forceinline__ void ffn_fix(const Frame& F, CArgs* A, int layer, const bf16* HB, const bf16* UPS, bf16* ACT) {
    const float* cw = A->in[I_FCW] + (size_t)layer * 3 * FF2; const float* cb = A->in[I_FCB] + (size_t)layer * FF2; const float* st = A->in[I_SFC] + (size_t)layer * SB * 2 * FF2;
    constexpr int NSLAB = MP / 64;
    for (int idx = F.gt; idx < (NSLAB + SB) * 768; idx += F.ngt) {
        const int rb = idx / 768, c = (idx - rb * 768) * 8; const bool is_s = rb >= NSLAB;
        f32x4 wq[3][4], bq[4];
#pragma unroll
        for (int k = 0; k < 3; ++k) { wq[k][0] = *(const f32x4*)(cw + (size_t)k * FF2 + c); wq[k][1] = *(const f32x4*)(cw + (size_t)k * FF2 + c + 4); wq[k][2] = *(const f32x4*)(cw + (size_t)k * FF2 + FF + c); wq[k][3] = *(const f32x4*)(cw + (size_t)k * FF2 + FF + c + 4); }
        bq[0] = *(const f32x4*)(cb + c); bq[1] = *(const f32x4*)(cb + c + 4); bq[2] = *(const f32x4*)(cb + FF + c); bq[3] = *(const f32x4*)(cb + FF + c + 4);
        float g2[8], g1[8], v2[8], v1[8];
        if (!is_s) {
            const int s = rb; const bf16* hb = HB + (size_t)s * 4 * FF2 + c; const bool first = (s & 63) == 0, lastslab = (s & 63) == 63;
            v4u hg[4], hv[4];
            const bf16* hp = first ? hb : hb - 2 * FF2;
            hg[0] = *(const v4u*)(hp); hg[1] = *(const v4u*)(hp + FF2); hv[0] = *(const v4u*)(hp + FF); hv[1] = *(const v4u*)(hp + FF2 + FF);
            hg[2] = *(const v4u*)(hb); hg[3] = *(const v4u*)(hb + FF2); hv[2] = *(const v4u*)(hb + FF); hv[3] = *(const v4u*)(hb + FF2 + FF);
            v4u tg[2], tv[2];
            if (lastslab) { tg[0] = *(const v4u*)(hb + (size_t)2 * FF2); tg[1] = *(const v4u*)(hb + (size_t)3 * FF2); tv[0] = *(const v4u*)(hb + (size_t)2 * FF2 + FF); tv[1] = *(const v4u*)(hb + (size_t)3 * FF2 + FF); }
            __builtin_amdgcn_sched_barrier(0);
            unpack8(hg[0], g2); unpack8(hg[1], g1); unpack8(hv[0], v2); unpack8(hv[1], v1);
            if (first) {
#pragma unroll
                for (int e = 0; e < 8; ++e) { g2[e] = 0.f; g1[e] = 0.f; v2[e] = 0.f; v1[e] = 0.f; } }
#pragma unroll
            for (int r = 0; r < 2; ++r) { float ug[8], uv[8], o[8]; unpack8(hg[2 + r], ug); unpack8(hv[2 + r], uv);
#pragma unroll
                for (int e = 0; e < 8; ++e) { const float gg = bq[e >> 2][e & 3] + wq[0][e >> 2][e & 3] * g2[e] + wq[1][e >> 2][e & 3] * g1[e] + wq[2][e >> 2][e & 3] * ug[e];
                    const float vv = bq[2 + (e >> 2)][e & 3] + wq[0][2 + (e >> 2)][e & 3] * v2[e] + wq[1][2 + (e >> 2)][e & 3] * v1[e] + wq[2][2 + (e >> 2)][e & 3] * uv[e]; o[e] = gelu_tanh(gg) * vv; }
                *(v4u*)(ACT + (size_t)(s * 64 + r) * FF + c) = pack8(o);
#pragma unroll
                for (int e = 0; e < 8; ++e) { g2[e] = g1[e]; g1[e] = ug[e]; v2[e] = v1[e]; v1[e] = uv[e]; } }
            if (lastslab) {
#pragma unroll
                for (int r = 0; r < 2; ++r) { float ug[8], uv[8]; unpack8(tg[r], ug); unpack8(tv[r], uv);
                    float* dst = A->out + O_FCP + ((size_t)(layer * 2 + (s >> 6)) * 2 + r) * FF2 + c; store8f(dst, ug); store8f(dst + FF, uv); } }
        } else {
            const int sb = rb - NSLAB;
            f32x4 sq[2][4]; v4u ug4[ST], uv4[ST];
#pragma unroll
            for (int r = 0; r < 2; ++r) { const float* sp = st + ((size_t)sb * 2 + r) * FF2 + c; sq[r][0] = *(const f32x4*)sp; sq[r][1] = *(const f32x4*)(sp + 4); sq[r][2] = *(const f32x4*)(sp + FF); sq[r][3] = *(const f32x4*)(sp + FF + 4); }
#pragma unroll
            for (int r = 0; r < ST; ++r) { const bf16* up = UPS + (size_t)(sb * ST + r) * FF2 + c; ug4[r] = *(const v4u*)up; uv4[r] = *(const v4u*)(up + FF); }
            __builtin_amdgcn_sched_barrier(0);
#pragma unroll
            for (int e = 0; e < 8; ++e) { g2[e] = sq[0][e >> 2][e & 3]; g1[e] = sq[1][e >> 2][e & 3]; v2[e] = sq[0][2 + (e >> 2)][e & 3]; v1[e] = sq[1][2 + (e >> 2)][e & 3]; }
#pragma unroll
            for (int r = 0; r < ST; ++r) { float ug[8], uv[8], o[8]; unpack8(ug4[r], ug); unpack8(uv4[r], uv);
#pragma unroll
                for (int e = 0; e < 8; ++e) { const float gg = bq[e >> 2][e & 3] + wq[0][e >> 2][e & 3] * g2[e] + wq[1][e >> 2][e & 3] * g1[e] + wq[2][e >> 2][e & 3] * ug[e];
                    const float vv = bq[2 + (e >> 2)][e & 3] + wq[0][2 + (e >> 2)][e & 3] * v2[e] + wq[1][2 + (e >> 2)][e & 3] * v1[e] + wq[2][2 + (e >> 2)][e & 3] * uv[e]; o[e] = gelu_tanh(gg) * vv; }
                *(v4u*)(ACT + (size_t)(MP + sb * ST + r) * FF + c) = pack8(o);
                if (r >= 2) { float* dst = A->out + O_FCS + ((size_t)(layer * SB + sb) * 2 + (r - 2)) * FF2 + c; store8f(dst, ug); store8f(dst + FF, uv); }
#pragma unroll
                for (int e = 0; e < 8; ++e) { g2[e] = g1[e]; g1[e] = ug[e]; v2[e] = v1[e]; v1[e] = uv[e]; } }
        }
    }
}
constexpr int ATT_K_OFF = 0, ATT_V_OFF = 65536, ATT_S_OFF = 131072;
__device__ __forceinline__ void attn_decode(int tile, int& b, int& g, int& h, int& dil, int& p, int& n) {
    const int idx32 = tile & 31, bgh = tile >> 5; h = bgh & 7; g = (bgh >> 3) % 3; b = bgh / 24;
    dil = g == 0 ? 1 : (g == 1 ? 4 : 16); const int nb = 32 / dil; p = idx32 / nb; n = idx32 - p * nb;
}
#define ATT_PREFETCH_BLK(kbase_, blk_) do { const bf16* ks_ = (kbase_) + (size_t)((blk_) * 128 + kq) * 128 + ch * 8; \
        _Pragma("unroll") for (int i = 0; i < 4; ++i) { kraw[i] = *(const v4u*)(ks_ + (size_t)i * 32 * 128); vraw[i] = *(const v4u*)(ks_ + (size_t)i * 32 * 128 + (size_t)8 * 2 * 4096 * 128); } } while (0)
#define ATT_PREFETCH_Q(qbase_, blk_) do { const bf16* qb_ = (qbase_) + (size_t)((blk_) * 128 + 16 * w + fr) * 128 + 8 * fq; \
        _Pragma("unroll") for (int ks = 0; ks < 4; ++ks) bq[ks] = *(const bf16x8*)(qb_ + 32 * ks); } while (0)
typedef short att_v4i16 __attribute__((ext_vector_type(4)));
__device__ __forceinline__ void attn_prompt(const Frame& F, const bf16* QKV, bf16* OG, float* LSE) {
    LAS unsigned char* Kl = F.lds + RING_OFF + ATT_K_OFF;
    LAS unsigned char* Vl = F.lds + RING_OFF + ATT_V_OFF;
    const int w = F.wave;
    v4u kraw[4], vraw[4]; bf16x8 bq[4];
    for (int run = F.bx; run < 512; run += F.G) {
        int g, b, h, p, n0, nt;
        if (run < 256) { const int a = run & 127; g = run >> 7; b = a >> 6; h = (a >> 3) & 7; if (g == 0) { p = 0; n0 = 4 * (a & 7); } else { p = (a >> 1) & 3; n0 = 4 * (a & 1); } nt = 4; }
        else { const int c = run - 256; g = 2; b = c >> 7; h = (c >> 4) & 7; p = c & 15; n0 = 0; nt = 2; }
        const int dil = 1 << (2 * g), Lp = TSEQ >> (2 * g);
        const float slope = exp2f(-8.0f * (float)(g * 8 + h + 1) / 24.0f);
        const bf16* kbase = QKV + ((size_t)((g * 3 + 1) * 8 + h) * 2 + b) * (4096 * 128) + (size_t)(p * Lp) * 128;
        const bf16* qbase = QKV + ((size_t)((g * 3 + 0) * 8 + h) * 2 + b) * (4096 * 128) + (size_t)(p * Lp) * 128;
        const size_t orow0 = (size_t)g * MT + (size_t)b * TSEQ;
        { int lane_ = F.lane; asm volatile("" : "+v"(lane_)); const int kq = w * 4 + (lane_ >> 4), ch = lane_ & 15;
          if (n0 > 0) ATT_PREFETCH_BLK(kbase, n0 - 1); else {
#pragma unroll
              for (int i = 0; i < 4; ++i) { kraw[i] = (v4u){0u, 0u, 0u, 0u}; vraw[i] = (v4u){0u, 0u, 0u, 0u}; } } }
        for (int s = -1; s < nt; ++s) {
            const int n = n0 + s;
            int lane_ = F.lane; asm volatile("" : "+v"(lane_));
            const int fr = lane_ & 15, fq = lane_ >> 4, kq = w * 4 + (lane_ >> 4), ch = lane_ & 15;
            const int half = (n & 1) * 128;
#pragma unroll
            for (int i = 0; i < 4; ++i) { const int key = half + 32 * i + kq;
                *(LAS v4u*)(Kl + key * 256 + ((ch ^ (key & 15)) << 4)) = kraw[i];
                *(LAS v4u*)(Vl + key * 256 + ((((ch >> 1) ^ (key & 7)) << 5) | ((ch & 1) << 4))) = vraw[i]; }
            __syncthreads();
            if (s + 1 < nt) { ATT_PREFETCH_BLK(kbase, n + 1); if (s < 0) ATT_PREFETCH_Q(qbase, n + 1); }
            if (s >= 0) {
                const int tq = (128 * n + 16 * w + fr) * dil + p;
                const int hp = 128 - half;
                f32x4 S[10];
#pragma unroll
                for (int kb = 0; kb < 9; ++kb) { const int j = 16 * w + 16 * kb + fr; const int rowk = (j < 128 ? hp : half - 128) + j;
                    const LAS unsigned char* kp = Kl + rowk * 256; f32x4 acc = {0.f, 0.f, 0.f, 0.f};
#pragma unroll
                    for (int ks = 0; ks < 4; ++ks) { const bf16x8 ak = *(const LAS bf16x8*)(kp + (((4 * ks + fq) ^ fr) << 4)); acc = __builtin_amdgcn_mfma_f32_16x16x32_bf16(ak, bq[ks], acc, 0, 0, 0); }
                    S[kb] = acc; }
                if (s + 1 < nt) ATT_PREFETCH_Q(qbase, n + 1);
                float mx = -3.0e38f;
                {
                    const int dj0 = 4 * fq - fr;
                    const float c1 = slope * (float)dil, t0 = c1 * (float)(dj0 - 128); const int jj0 = (n > 0) ? 1024 : 16 * w + 4 * fq;
#pragma unroll
                    for (int kb = 0; kb < 9; ++kb)
#pragma unroll
                        for (int r = 0; r < 4; ++r) { const int dj = dj0 + (16 * kb + r); const bool valid = (unsigned)dj <= 128u && jj0 + (16 * kb + r) >= 128;
                            const float sv = fmaf(c1, (float)(16 * kb + r), fmaf(S[kb][r], 0.08838834764831845f, t0)); S[kb][r] = valid ? sv : -1.0e30f; mx = fmaxf(mx, S[kb][r]); }
                }
                mx = fmaxf(mx, xshf<16>(mx)); mx = half_max(mx);
                float den = 0.f;
#pragma unroll
                for (int kb = 0; kb < 9; ++kb)
#pragma unroll
                    for (int r = 0; r < 4; ++r) { const float pp = __expf(S[kb][r] - mx); S[kb][r] = pp; den += pp; }
                S[9] = (f32x4){0.f, 0.f, 0.f, 0.f};
                den += xshf<16>(den); den = half_sum(den);
                f32x4 O[8];
#pragma unroll
                for (int db = 0; db < 8; ++db) O[db] = (f32x4){0.f, 0.f, 0.f, 0.f};
#pragma unroll
                for (int ps = 0; ps < 5; ++ps) { const int kbA = 2 * ps, kbB = 2 * ps + 1;
                    v4u pw; pw.x = cvt_pk_bf16(S[kbA][0], S[kbA][1]); pw.y = cvt_pk_bf16(S[kbA][2], S[kbA][3]); pw.z = cvt_pk_bf16(S[kbB][0], S[kbB][1]); pw.w = cvt_pk_bf16(S[kbB][2], S[kbB][3]);
                    const bf16x8 pb = __builtin_bit_cast(bf16x8, pw);
                    int jA = 16 * w + 16 * kbA + 4 * fq, jB = jA + 16; jA = jA > 252 ? 252 : jA; jB = jB > 252 ? 252 : jB;
                    const int keyA = (jA < 128 ? hp : half - 128) + jA + (fr >> 2), keyB = (jB < 128 ? hp : half - 128) + jB + (fr >> 2);
                    const LAS unsigned char* vA = Vl + keyA * 256 + ((fr & 3) << 3); const LAS unsigned char* vB = Vl + keyB * 256 + ((fr & 3) << 3);
#pragma unroll
                    for (int db = 0; db < 8; ++db) {
                        const att_v4i16 lo = __builtin_amdgcn_ds_read_tr16_b64_v4i16((LAS att_v4i16*)(vA + ((db ^ (keyA & 7)) << 5)));
                        const att_v4i16 hi = __builtin_amdgcn_ds_read_tr16_b64_v4i16((LAS att_v4i16*)(vB + ((db ^ (keyB & 7)) << 5)));
                        const bf16x8 av = __builtin_shufflevector(lo, hi, 0, 1, 2, 3, 4, 5, 6, 7);
                        O[db] = __builtin_amdgcn_mfma_f32_16x16x32_bf16(av, pb, O[db], 0, 0, 0); } }
                const float inv = 1.0f / den; const size_t row = orow0 + tq;
#pragma unroll
                for (int db = 0; db < 8; ++db) { const f32x4 o = O[db] * inv; v2u w2; w2.x = cvt_pk_bf16(o[0], o[1]); w2.y = cvt_pk_bf16(o[2], o[3]); *(v2u*)(OG + row * AW + h * 128 + 16 * db + 4 * fq) = w2; }
                if (fq == 0) LSE[row * 8 + h] = mx + __logf(den);
            }
            __syncthreads();
        }
    }
}
__device__ __forceinline__ void attn_sample(const Frame& F, CArgs* A, int j, const bf16* QKV, bf16* OG, float* LSE) {
    LAS float* sm = (LAS float*)(F.lds + RING_OFF + ATT_S_OFF) + F.wave * 512;
    LAS float* qs = sm; LAS float* ps = sm + 128; LAS float* os = sm + 192; LAS float* ms = sm + 320;
    const int lane = F.lane, hf = F.wave & 1;
    float kscale = 0.08838834764831845f; asm volatile("" : "+s"(kscale));
    constexpr int NIT = SB * ST * 24;
    for (int it0 = F.bx; it0 < NIT; it0 += 4 * F.G) {
        const int it = it0 + F.G * (F.wave >> 1); const bool valid = it < NIT;
        float mx = 0.f, den = 1.f, o0 = 0.f, o1 = 0.f; size_t obase = 0, lbase = 0;
        if (valid) {
            const int h = it & 7, g = (it >> 3) % 3, t = (it / 24) & 3, b = it / 96;
            const int dil = g == 0 ? 1 : (g == 1 ? 4 : 16), win = 128 * dil;
            const float slope = exp2f(-8.0f * (float)(g * 8 + h + 1) / 24.0f);
            const float* cache = A->in[I_C128 + g] + ((size_t)(j * SB + b) * win) * 2048 + h * 128;
            const float* newkv = A->out + O_KVS0 + (size_t)g * (O_KVS1 - O_KVS0) + ((size_t)(j * SB + b) * ST) * 2048 + h * 128;
            const size_t orow = (size_t)g * MT + MP + b * ST + t; obase = orow * AW + h * 128; lbase = orow * 8 + h;
            const unsigned qw = *(const unsigned*)(QKV + (size_t)(b * ST + t) * NQKV + g * 3072 + h * 128 + 2 * lane);
            const int s = 64 * hf + lane, idx = win + t - s * dil;
            const float* kr = idx < win ? cache + (size_t)idx * 2048 : newkv + (size_t)(idx - win) * 2048;
            f32x2 k128 = (f32x2){0.f, 0.f};
            if (hf) k128 = *(const f32x2*)(cache + (size_t)t * 2048 + 2 * lane);
            *(LAS f32x2*)(qs + 2 * lane) = (f32x2){bf_lo(qw), bf_hi(qw)};
            LDS_WAIT();
            float acc = 0.f;
            f32x4 kk[32];
#pragma unroll
            for (int c = 0; c < 32; ++c) kk[c] = *(const f32x4*)(kr + 4 * c);
#pragma unroll
            for (int c0 = 0; c0 < 32; c0 += 8) { LAS float* qc = qs; asm volatile("" : "+v"(qc) : "v"(acc));
#pragma unroll
                for (int c = c0; c < c0 + 8; ++c) { const f32x4 qq = *(const LAS f32x4*)(qc + 4 * c); acc += (kk[c].x * qq.x + kk[c].y * qq.y) + (kk[c].z * qq.z + kk[c].w * qq.w); } }
            const float sc = acc * kscale - slope * (float)(s * dil);
            float sc128 = -3.0e38f;
            if (hf) { const f32x2 q2 = *(const LAS f32x2*)(qs + 2 * lane); sc128 = wave_sum(k128.x * q2.x + k128.y * q2.y) * kscale - slope * (float)(128 * dil); }
            mx = fmaxf(wave_max(sc), sc128);
            const float p = __expf(sc - mx), p128 = hf ? __expf(sc128 - mx) : 0.f;
            den = wave_sum(p) + p128;
            ps[lane] = p;
            LDS_WAIT();
#pragma nounroll
            for (int e0 = 0; e0 < 64; e0 += 32) {
                f32x2 vv[32];
#pragma unroll
                for (int e = 0; e < 32; ++e) { const int ix = win + t - (64 * hf + e0 + e) * dil;
                    const float* vr = (ix < win ? cache + (size_t)ix * 2048 : newkv + (size_t)(ix - win) * 2048) + 1024; vv[e] = *(const f32x2*)(vr + 2 * lane); }
#pragma unroll
                for (int e = 0; e < 32; ++e) { const float pp = ps[e0 + e]; o0 += pp * vv[e].x; o1 += pp * vv[e].y; }
            }
            if (hf) { const f32x2 v128 = *(const f32x2*)(cache + (size_t)t * 2048 + 1024 + 2 * lane); o0 += p128 * v128.x; o1 += p128 * v128.y;
                *(LAS f32x2*)(os + 2 * lane) = (f32x2){o0, o1}; if (lane == 0) { ms[0] = mx; ms[1] = den; } }
        }
        __syncthreads();
        if (valid && hf == 0) {
            const float mx1 = ms[512], den1 = ms[513]; const f32x2 ob = *(const LAS f32x2*)(os + 512 + 2 * lane);
            const float M = fmaxf(mx, mx1), a0 = __expf(mx - M), a1 = __expf(mx1 - M);
            const float dn = den * a0 + den1 * a1, inv = 1.0f / dn;
            *(unsigned*)(OG + obase + 2 * lane) = cvt_pk_bf16((o0 * a0 + ob.x * a1) * inv, (o1 * a0 + ob.y * a1) * inv);
            if (lane == 0) LSE[lbase] = M + __logf(dn);
        }
        __syncthreads();
    }
}
__device__ __forceinline__ void kv_prompt_out(const Frame& F, CArgs* A, int j, const bf16* QKV) {
#pragma unroll 4
    for (int idx = F.gt; idx < 5376 * 256; idx += F.ngt) {
        const int c = (idx & 127) * 8, kv = (idx >> 7) & 1; int rr = idx >> 8; int g, keep; size_t obase;
        if (rr < 256) { g = 0; keep = 128; obase = O_KVP0; } else if (rr < 1280) { g = 1; keep = 512; rr -= 256; obase = O_KVP1; } else { g = 2; keep = 2048; rr -= 1280; obase = O_KVP2; }
        const int b = rr / keep, r = rr - b * keep;
        const int t = TSEQ - keep + r, dsh = 2 * g, pos = ((t & ((1 << dsh) - 1)) << (12 - dsh)) + (t >> dsh);
        float x[8]; unpack8(*(const v4u*)(QKV + ((size_t)((g * 3 + 1 + kv) * 8 + (c >> 7)) * 2 + b) * (4096 * 128) + (size_t)pos * 128 + (c & 127)), x);
        store8f(A->out + obase + (((size_t)(j * 2 + b) * keep + r) * 2 + kv) * 1024 + c, x);
    }
}
__device__ __forceinline__ void attn_combine(const Frame& F, const bf16* OG, const float* LSE, bf16* O) {
#pragma unroll 4
    for (int idx = F.gt; idx < MT * 128; idx += F.ngt) {
        const int m = idx >> 7, hc = idx & 127, h = hc >> 4;
        const float l0 = LSE[((size_t)0 * MT + m) * 8 + h], l1 = LSE[((size_t)1 * MT + m) * 8 + h], l2 = LSE[((size_t)2 * MT + m) * 8 + h];
        const float mx = fmaxf(fmaxf(l0, l1), l2); float w0 = __expf(l0 - mx), w1 = __expf(l1 - mx), w2 = __expf(l2 - mx); const float inv = 1.0f / (w0 + w1 + w2); w0 *= inv; w1 *= inv; w2 *= inv;
        float a[8], bb[8], cc[8], o[8];
        unpack8(*(const v4u*)(OG + ((size_t)0 * MT + m) * AW + hc * 8), a); unpack8(*(const v4u*)(OG + ((size_t)1 * MT + m) * AW + hc * 8), bb); unpack8(*(const v4u*)(OG + ((size_t)2 * MT + m) * AW + hc * 8), cc);
#pragma unroll
        for (int e = 0; e < 8; ++e) o[e] = w0 * a[e] + w1 * bb[e] + w2 * cc[e];
        *(v4u*)(O + (size_t)m * AW + hc * 8) = pack8(o);
    }
}

#define PH const Frame F = mk_frame((LAS unsigned char*)lds, wv0); CArgs* A = kargs(); unsigned char* const ws = A->ws; LAS unsigned char* const ring = F.lds + RING_OFF; (void)ring; (void)ws;
#define P_X ((float*)(ws + WS_X))
#define P_XS (P_X + (size_t)MP * DM)
#define P_XN ((bf16*)(ws + WS_XN))
#define P_S (ws + WS_S)
#define P_GG ((bf16*)(P_S + S_GG))
#define P_U ((bf16*)(P_S + S_U))
#define P_UC ((bf16*)(P_S + S_UC))
#define P_HG ((bf16*)(P_S + S_HG))
#define P_LA ((bf16*)(P_S + S_LA))
#define P_GI ((bf16*)(P_S + S_GI))
#define P_QKV ((bf16*)(P_S + S_QKV))
#define P_QS (P_QKV + (size_t)MP * NQKV)
#define P_OG ((bf16*)(P_S + S_OG))
#define P_LSE ((float*)(P_S + S_LSE))
#define P_OB ((bf16*)(P_S + S_O))
#define P_UPS ((bf16*)(P_S + S_UPS))
#define P_HB ((bf16*)(P_S + S_HB))
#define P_ACT ((bf16*)(P_S + S_ACT))
#define P_CA ((float*)(ws + WS_SC))
#define P_CB ((float*)(ws + WS_SC + 1 * MiB))
#define P_HIN ((float*)(ws + WS_SC + 2 * MiB))
#define P_SP ((float*)(ws + WS_MISC))
#define P_SSP(k) ((float*)(ws + WS_SSP) + (size_t)(k) * MP * 8)
#define P_SSS(k) ((float*)(ws + WS_SSS) + (size_t)(k) * 32 * 128)
#define P_T ((pg8::PG8_LAS_T)(F.lds + EPI_T_OFF))
__global__ void __launch_bounds__(NWAVES * 64, 2) fwd(Args args_unused) {
    extern __shared__ __attribute__((aligned(16))) unsigned char lds[];
    XcdBarrier bar;
    const int wv0 = __builtin_amdgcn_readfirstlane((int)(threadIdx.x >> 6));
    {
        PH;
        for (int u = F.tid; u < (LDS_BYTES - LDSCTL_OFF) / 4; u += NTHR) ((LAS unsigned*)(F.lds + LDSCTL_OFF))[u] = 0u;
        __syncthreads();
        bar = xcd_barrier_post((unsigned*)((gu32*)(ws + WS_CTL) + CW_BAR), (volatile LAS unsigned*)(F.lds + MISC_OFF) + 8, wv0);
        p0_prologue(F, A, ws);
    }
    xcd_barrier(bar);

#pragma nounroll
    for (int pair = 0; pair < DEPTH / 2; ++pair) {
        {   const int layer = 2 * pair; const int j = layer >> 1; (void)j;
            {   PH;
                const bf16* Wl = (bf16*)(ws + WS_WIN) + (size_t)j * 4096 * DM; const float* b_in = A->in[I_LBIN] + (size_t)j * 4096;
                TWin fn{P_GG, P_U, b_in}; thin_gemm<1>(F, P_XN + (size_t)MP * DM, DM, 0, Wl, 4096, DM, fn, P_SSS(2 * layer));
                pg8::Gemm g{P_XN, Wl, MP, 4096, DM, DM, 0}; pg8::StaticOrder So; So.init(MP, 4096, F.G, F.bx);
                pg8::EpiBf<1> E{P_GG, DM, b_in, P_U, P_SSP(2 * layer)};
                pg8::gemm_phase<pg8::EpiBf<1>, pg8::StaticOrder, PG8_ALIGN, PG8_SP2>(ring, g, So, E, F.wave);
            }
            xcd_barrier(bar);
            {   PH;
                lru_conv_own(F, A, j, P_U, P_UC);
                const bf16* Gl = (bf16*)(ws + WS_GT) + (size_t)j * 4096 * 256; const float* b_a = A->in[I_LBA] + (size_t)j * 2048; const float* b_i = A->in[I_LBI] + (size_t)j * 2048; const float* sp = P_SP + (size_t)j * 2048;
                TGates fn{P_LA, P_GI, P_UC, b_a, b_i, sp}; thin_gemm<1>(F, P_UC + (size_t)MP * DM, DM, 8, Gl, 4096, 256, fn);
                pg8::Gemm g{P_UC, Gl, MP, 4096, 256, DM, 8}; pg8::GatesOrder So; So.init(F.G, F.bx);
                pg8::EpiGates E{P_LA, P_GI, P_UC, b_a, b_i, sp};
                pg8::gemm_phase<pg8::EpiGates, pg8::GatesOrder, PG8_ALIGN, PG8_SP2>(ring, g, So, E, F.wave);
            }
            xcd_barrier(bar);
            {   PH; scan_pass1(F, P_LA, P_GI, P_CA, P_CB); }
            xcd_barrier(bar);
            {   PH; scan_pass2(F, P_CA, P_CB, P_HIN); }
            xcd_barrier(bar);
            {   PH; scan_pass3(F, A, j, P_LA, P_GI, P_HIN, P_GG, P_HG); }
            xcd_barrier(bar);
            {   PH;
                const bf16* Wo = (bf16*)(ws + WS_WOUT) + (size_t)j * DM * DM; const float* b_out = A->in[I_LBOUT] + (size_t)j * DM;
                TResid fn{P_XN + (size_t)MP * DM, b_out, P_SSS(2 * layer + 1)}; thin_gemm<1>(F, P_HG + (size_t)MP * DM, DM, 0, Wo, DM, DM, fn);
                pg8::Gemm g{P_HG, Wo, MP, DM, DM, DM, 0}; pg8::StaticOrder So; So.init(MP, DM, F.G, F.bx);
                pg8::EpiResid E{P_XN, DM, b_out, P_SSP(2 * layer + 1), P_T};
                pg8::gemm_phase<pg8::EpiResid, pg8::StaticOrder, PG8_ALIGN, PG8_SP2>(ring, g, So, E, F.wave);
            }
            xcd_barrier(bar);
        }
        {   const int layer = 2 * pair; const int j = layer >> 1; (void)j;
        {   PH;
            const bf16* Wl = (bf16*)(ws + WS_WUP) + (size_t)layer * FF2 * DM;
            TUp fn{P_UPS}; thin_gemm<3>(F, P_XN + (size_t)MP * DM, DM, 0, Wl, FF2, DM, fn, P_SSS(2 * layer + 1));
            pg8::Gemm g{P_XN, Wl, MP, FF2, DM, DM, 0}; pg8::StaticOrder So; So.init(MP, FF2, F.G, F.bx);
            pg8::EpiUpGlu E{P_ACT, P_HB, A->in[I_FCW] + (size_t)layer * 3 * FF2, A->in[I_FCB] + (size_t)layer * FF2, P_SSP(2 * layer + 1)};
            pg8::gemm_phase<pg8::EpiUpGlu, pg8::StaticOrder, PG8_ALIGN, PG8_SP2>(ring, g, So, E, F.wave);
        }
        xcd_barrier(bar);
        {   PH; ffn_fix(F, A, layer, P_HB, P_UPS, P_ACT); }
        xcd_barrier(bar);
        {   PH;
            const bf16* Wl = (bf16*)(ws + WS_WDN) + (size_t)layer * DM * FF;
            TResid fn{P_XN + (size_t)MP * DM, nullptr, P_SSS(2 * layer + 2)}; thin_gemm<1, 12>(F, P_ACT + (size_t)MP * FF, FF, 0, Wl, DM, FF, fn);
            pg8::Gemm g{P_ACT, Wl, MP, DM, FF, FF, 0}; pg8::StaticOrder So; So.init(MP, DM, F.G, F.bx);
            pg8::EpiResid E{P_XN, DM, nullptr, P_SSP(2 * layer + 2), P_T};
            pg8::gemm_phase<pg8::EpiResid, pg8::StaticOrder, PG8_ALIGN, PG8_SP2>(ring, g, So, E, F.wave);
        }
        xcd_barrier(bar);
        if (layer == DEPTH - 1) { PH; norm_rows_out(F, P_XN, A->in[I_NFIN], A->out + O_YP, A->out + O_YS); }
        }
        {   const int layer = 2 * pair + 1; const int j = layer >> 1; (void)j;
            {   PH;
                const bf16* Wl = (bf16*)(ws + WS_WQKV) + (size_t)j * NQKV * DM;
                {   constexpr int NU = (MP / 256) * (NQKV / 256); const int rounds = (NU + F.G - 1) / F.G; int c0 = NU - (rounds - 1) * F.G; if (c0 >= F.G) c0 = 0;
                    if (F.bx >= c0) { Frame F2 = F; F2.bx = F.bx - c0; F2.G = F.G - c0; TQkv fn{P_QS, A->out + O_KVS0, j}; thin_gemm<3>(F2, P_XN + (size_t)MP * DM, DM, 0, Wl, NQKV, DM, fn, P_SSS(2 * layer)); } }
                pg8::Gemm g{P_XN, Wl, MP, NQKV, DM, DM, 0}; pg8::StaticOrder So; So.init(MP, NQKV, F.G, F.bx);
                pg8::EpiQkv E{P_QKV, P_SSP(2 * layer)};
                pg8::gemm_phase<pg8::EpiQkv, pg8::StaticOrder, PG8_ALIGN, PG8_SP2>(ring, g, So, E, F.wave);
            }
            xcd_barrier(bar);
            {   PH; attn_sample(F, A, j, P_QS, P_OG, P_LSE); __syncthreads(); attn_prompt(F, P_QKV, P_OG, P_LSE); kv_prompt_out(F, A, j, P_QKV); }
            xcd_barrier(bar);
            {   PH; attn_combine(F, P_OG, P_LSE, P_OB); }
            xcd_barrier(bar);
            {   PH;
                const bf16* Wo = (bf16*)(ws + WS_WO) + (size_t)j * DM * AW;
                TResid fn{P_XN + (size_t)MP * DM, nullptr, P_SSS(2 * layer + 1)}; thin_gemm<1>(F, P_OB + (size_t)MP * AW, AW, 0, Wo, DM, AW, fn);
                pg8::Gemm g{P_OB, Wo, MP, DM, AW, AW, 0}; pg8::StaticOrder So; So.init(MP, DM, F.G, F.bx);
                pg8::EpiResid E{P_XN, DM, nullptr, P_SSP(2 * layer + 1), P_T};
                pg8::gemm_phase<pg8::EpiResid, pg8::StaticOrder, PG8_ALIGN, PG8_SP2>(ring, g, So, E, F.wave);
            }
            xcd_barrier(bar);
        }
        {   const int layer = 2 * pair + 1; const int j = layer >> 1; (void)j;
        {   PH;
            const bf16* Wl = (bf16*)(ws + WS_WUP) + (size_t)layer * FF2 * DM;
            TUp fn{P_UPS}; thin_gemm<3>(F, P_XN + (size_t)MP * DM, DM, 0, Wl, FF2, DM, fn, P_SSS(2 * layer + 1));
            pg8::Gemm g{P_XN, Wl, MP, FF2, DM, DM, 0}; pg8::StaticOrder So; So.init(MP, FF2, F.G, F.bx);
            pg8::EpiUpGlu E{P_ACT, P_HB, A->in[I_FCW] + (size_t)layer * 3 * FF2, A->in[I_FCB] + (size_t)layer * FF2, P_SSP(2 * layer + 1)};
            pg8::gemm_phase<pg8::EpiUpGlu, pg8::StaticOrder, PG8_ALIGN, PG8_SP2>(ring, g, So, E, F.wave);
        }
        xcd_barrier(bar);
        {   PH; ffn_fix(F, A, layer, P_HB, P_UPS, P_ACT); }
        xcd_barrier(bar);
        {   PH;
            const bf16* Wl = (bf16*)(ws + WS_WDN) + (size_t)layer * DM * FF;
            TResid fn{P_XN + (size_t)MP * DM, nullptr, P_SSS(2 * layer + 2)}; thin_gemm<1, 12>(F, P_ACT + (size_t)MP * FF, FF, 0, Wl, DM, FF, fn);
            pg8::Gemm g{P_ACT, Wl, MP, DM, FF, FF, 0}; pg8::StaticOrder So; So.init(MP, DM, F.G, F.bx);
            pg8::EpiResid E{P_XN, DM, nullptr, P_SSP(2 * layer + 2), P_T};
            pg8::gemm_phase<pg8::EpiResid, pg8::StaticOrder, PG8_ALIGN, PG8_SP2>(ring, g, So, E, F.wave);
        }
        xcd_barrier(bar);
        if (layer == DEPTH - 1) { PH; norm_rows_out(F, P_XN, A->in[I_NFIN], A->out + O_YP, A->out + O_YS); }
        }
    }
}

extern "C" void kernel_launch(void* const* d_in, const int* in_sizes, int n_in, void* d_out, int out_size, void* d_ws, size_t ws_size, hipStream_t stream) {
    static int grid = 0;
    if (grid == 0) {
        if (n_in != N_IN || (size_t)out_size != O_END || ws_size < WS_END) { fprintf(stderr, "kernel_launch: unexpected shapes: n_in %d out %d ws %zu (need %zu)\n", n_in, out_size, ws_size, (size_t)WS_END); grid = -1; return; }
        int dev = 0, cus = 0, per_cu = 0;
        if (hipGetDevice(&dev) != hipSuccess || hipDeviceGetAttribute(&cus, hipDeviceAttributeMultiprocessorCount, dev) != hipSuccess) { grid = -1; return; }
        if (hipFuncSetAttribute((const void*)fwd, hipFuncAttributeMaxDynamicSharedMemorySize, LDS_BYTES) != hipSuccess) { fprintf(stderr, "kernel_launch: hipFuncSetAttribute failed\n"); grid = -1; return; }
        if (hipOccupancyMaxActiveBlocksPerMultiprocessor(&per_cu, (const void*)fwd, NWAVES * 64, LDS_BYTES) != hipSuccess || per_cu < 1) { fprintf(stderr, "kernel_launch: occupancy query reports %d blocks per CU\n", per_cu); }
        (void)hipGetLastError();
        grid = cus;
    }
    if (grid < 0) return;
    if (hipMemsetAsync((char*)d_ws + WS_CTL, 0, CTL_ZERO_BYTES, stream) != hipSuccess) return;
    Args a{};
    for (int i = 0; i < N_IN; ++i) a.in[i] = (const float*)d_in[i];
    a.out = (float*)d_out; a.ws = (unsigned char*)d_ws;
    hipLaunchKernelGGL(fwd, dim3(grid), dim3(NWAVES * 64), LDS_BYTES, stream, a);
}
```
